# Optimizing an MI355X kernel written in HIP

```python
import math
import jax, jax.numpy as jnp
from jax import lax
import numpy as np

D_MODEL = 1024
BATCH = 2
SEQ = 16384
DEPTH = 4

SSM_WIDTH = D_MODEL // 4
SSM_GROUP_CH = 16
SSM_GROUPS = SSM_WIDTH // SSM_GROUP_CH
SSM_STATE = 64
RET_HEAD_DIM = 64
RET_WIDTH = D_MODEL // 2
RET_HEADS = RET_WIDTH // RET_HEAD_DIM
SB_HEAD_DIM = 64
SB_WIDTH = D_MODEL // 4
SB_HEADS = SB_WIDTH // SB_HEAD_DIM
MIX_WIDTH = SSM_WIDTH + RET_WIDTH + SB_WIDTH
IN_COLS = SSM_WIDTH + 4 * RET_WIDTH + 3 * SB_WIDTH
RET_CHUNK = 128
SB_BLOCK = 128
ROPE_BASE = 10000.0
D_FF = 64 * ((8 * D_MODEL // 3 + 63) // 64)
D_FF_EXPERT = D_FF // 4
N_EXPERTS = 8
TOP_K = 2
N_DENSE = (DEPTH + 1) // 2
N_MOE = DEPTH // 2
ALPHA = (2.0 * DEPTH) ** 0.25
BETA_INIT = (8.0 * DEPTH) ** -0.25
LN_EPS = 1e-5

kernel_name = "hybrid_s5_retention_stickbreaking_moe"

F32 = jnp.float32
HI = lax.Precision.HIGHEST


def layer_norm(x, w, b):
    xf = x.astype(F32)
    mu = jnp.mean(xf, -1, keepdims=True)
    var = jnp.mean(jnp.square(xf - mu), -1, keepdims=True)
    y = (xf - mu) * lax.rsqrt(var + LN_EPS) * w.astype(F32) + b.astype(F32)
    return y.astype(x.dtype)


def head_rms_norm(x, w):
    xf = x.astype(F32)
    y = xf * lax.rsqrt(jnp.mean(xf * xf, -1, keepdims=True) + LN_EPS)
    return y * w.astype(F32)


def s5_mixer(u, lam_re, lam_im, log_dt, b_re, b_im, c_re, c_im, d_skip, glu_w, glu_b, norm_w):
    bsz, seq, _ = u.shape
    G, H, P = SSM_GROUPS, SSM_GROUP_CH, SSM_STATE
    ug = u.astype(F32).reshape(bsz, seq, G, H)
    lam = lax.complex(lam_re.astype(F32), lam_im.astype(F32))
    dt = jnp.exp(log_dt.astype(F32))[:, None]
    lam_bar = jnp.exp(lam * dt)
    b = lax.complex(b_re.astype(F32), b_im.astype(F32))
    b_bar = ((lam_bar - 1.0) / lam)[..., None] * b
    c = lax.complex(c_re.astype(F32), c_im.astype(F32))
    bu = jnp.einsum('gph,bsgh->bsgp', b_bar, ug.astype(jnp.complex64))
    a = jnp.broadcast_to(lam_bar, bu.shape)

    def combine(e1, e2):
        a1, s1 = e1
        a2, s2 = e2
        return a1 * a2, a2 * s1 + s2

    _, states = lax.associative_scan(combine, (a, bu), axis=1)
    y = jnp.einsum('ghp,bsgp->bsgh', c, states).real + d_skip.astype(F32).reshape(G, H) * ug
    g = jax.nn.gelu(y.reshape(bsz, seq, SSM_WIDTH))
    out = g * jax.nn.sigmoid(g @ glu_w.astype(F32) + glu_b.astype(F32))
    out = head_rms_norm(out.reshape(bsz, seq, G, H), norm_w.reshape(G, H))
    return out.reshape(bsz, seq, SSM_WIDTH).astype(u.dtype)


def rope(x, pos):
    half = x.shape[-1] // 2
    inv = ROPE_BASE ** (-jnp.arange(half, dtype=F32) / half)
    ang = pos[:, None] * inv[None, :]
    cos = jnp.cos(ang)[:, None, :]
    sin = jnp.sin(ang)[:, None, :]
    x1, x2 = x[..., :half], x[..., half:]
    return jnp.concatenate([x1 * cos - x2 * sin, x1 * sin + x2 * cos], axis=-1)


def retention_mixer(q, k, v, g, gn_w, gn_b):
    bsz, seq, _ = q.shape
    H, dh, C = RET_HEADS, RET_HEAD_DIM, RET_CHUNK
    n = seq // C
    pos = jnp.arange(seq, dtype=F32)
    qh = rope(q.astype(F32).reshape(bsz, seq, H, dh), pos)
    kh = rope(k.astype(F32).reshape(bsz, seq, H, dh), pos) * (dh ** -0.5)
    vh = v.astype(F32).reshape(bsz, seq, H, dh)
    log_gamma = jnp.log(1.0 - 2.0 ** (-5.0 - jnp.arange(H, dtype=F32)))

    def chunk(t):
        return t.reshape(bsz, n, C, H, dh).transpose(1, 0, 3, 2, 4)

    qc, kc, vc = chunk(qh), chunk(kh), chunk(vh)
    idx = jnp.arange(C, dtype=F32)
    rel = idx[:, None] - idx[None, :]
    decay_mask = jnp.where(rel >= 0, jnp.exp(log_gamma[:, None, None] * jnp.maximum(rel, 0.0)), 0.0)
    scores = jnp.einsum('nbhqd,nbhkd->nbhqk', qc, kc) * decay_mask
    inner = jnp.einsum('nbhqk,nbhkd->nbhqd', scores, vc)
    q_decay = jnp.exp(log_gamma[:, None] * (idx[None, :] + 1.0))
    k_decay = jnp.exp(log_gamma[:, None] * (C - 1.0 - idx[None, :]))
    chunk_decay = jnp.exp(log_gamma * C)

    def step(state, inp):
        kc_i, vc_i = inp
        new = chunk_decay[None, :, None, None] * state + jnp.einsum(
            'bhkd,bhke->bhde', kc_i * k_decay[None, :, :, None], vc_i)
        return new, state

    state0 = jnp.zeros((bsz, H, dh, dh), F32)
    _, prev_states = lax.scan(step, state0, (kc, vc))
    cross = jnp.einsum('nbhqd,nbhde->nbhqe', qc, prev_states) * q_decay[None, None, :, :, None]
    o = (inner + cross).transpose(1, 0, 3, 2, 4).reshape(bsz, seq, H, dh)
    mu = jnp.mean(o, -1, keepdims=True)
    var = jnp.mean(jnp.square(o - mu), -1, keepdims=True)
    o = (o - mu) * lax.rsqrt(var + LN_EPS) * gn_w.astype(F32).reshape(H, dh) + gn_b.astype(F32).reshape(H, dh)
    out = jax.nn.silu(g.astype(F32)) * o.reshape(bsz, seq, RET_WIDTH)
    return out.astype(q.dtype)


def stick_breaking_mixer(q, k, v, norm_w):
    bsz, seq, _ = q.shape
    H, dh, Bq = SB_HEADS, SB_HEAD_DIM, SB_BLOCK
    nb = seq // Bq
    scale = dh ** -0.5

    def heads(t):
        return t.astype(F32).reshape(bsz, seq, H, dh).transpose(0, 2, 1, 3)

    qh, kh, vh = heads(q), heads(k), heads(v)
    idx = jnp.arange(Bq)
    rev_incl = (idx[:, None] >= idx[None, :]).astype(F32)
    outs = []
    for bi in range(nb):
        L = (bi + 1) * Bq
        nkb = bi + 1
        qb = qh[:, :, bi * Bq:L]
        kb = kh[:, :, :L]
        vb = vh[:, :, :L]
        z = jnp.einsum('bhqd,bhkd->bhqk', qb, kb) * scale
        mask = jnp.arange(L)[None, :] < (bi * Bq + idx)[:, None]
        log_beta = jax.nn.log_sigmoid(z)
        log_1m = jnp.where(mask, log_beta - z, 0.0)
        blk = log_1m.reshape(bsz, H, Bq, nkb, Bq)
        within = jnp.einsum('bhqmj,js->bhqms', blk, rev_incl, precision=HI)
        later_mat = (jnp.arange(nkb)[:, None] > jnp.arange(nkb)[None, :]).astype(F32)
        later = jnp.einsum('bhqn,nm->bhqm', within[..., 0], later_mat, precision=HI)
        after = (within + later[..., None]).reshape(bsz, H, Bq, L) - log_1m
        a = jnp.where(mask, jnp.exp(log_beta + after), 0.0)
        outs.append(jnp.einsum('bhqk,bhkd->bhqd', a, vb))
    o = jnp.concatenate(outs, axis=2)
    o = o.transpose(0, 2, 1, 3)
    o = head_rms_norm(o, norm_w.reshape(H, dh))
    return o.reshape(bsz, seq, SB_WIDTH).astype(q.dtype)


def swiglu(x, w_gate, w_up, w_down):
    return (jax.nn.silu(x @ w_gate) * (x @ w_up)) @ w_down


def moe_swiglu(x, w_router, e_gate, e_up, e_down):
    bsz, seq, d = x.shape
    xt = x.reshape(-1, d)
    logits = (xt @ w_router).astype(F32)
    top_val, top_idx = lax.top_k(logits, TOP_K)
    top_w = jax.nn.softmax(top_val, axis=-1)
    gates = jnp.sum(jax.nn.one_hot(top_idx, N_EXPERTS, dtype=F32) * top_w[..., None], axis=1)
    out = jnp.zeros(xt.shape, F32)
    for e in range(N_EXPERTS):
        out = out + gates[:, e:e + 1] * swiglu(xt, e_gate[e], e_up[e], e_down[e]).astype(F32)
    return out.astype(x.dtype).reshape(bsz, seq, d)


def setup_inputs(seed: int = 0) -> dict:
    key = jax.random.key(seed)
    ks = iter(jax.random.split(key, 40))
    nrm = lambda shape, s: jax.random.normal(next(ks), shape, F32) * s
    G, H, P = SSM_GROUPS, SSM_GROUP_CH, SSM_STATE
    d_in = D_MODEL ** -0.5
    lam_im = jnp.broadcast_to(jnp.pi * jnp.arange(P, dtype=F32), (DEPTH, G, P)) + nrm((DEPTH, G, P), 0.01)
    return {
        "x": nrm((BATCH, SEQ, D_MODEL), 1.0),
        "w_in": nrm((DEPTH, D_MODEL, IN_COLS), d_in),
        "ssm_lam_re": -0.5 + nrm((DEPTH, G, P), 0.01),
        "ssm_lam_im": lam_im,
        "ssm_log_dt": jax.random.uniform(next(ks), (DEPTH, G), F32, math.log(0.001), math.log(0.1)),
        "ssm_b_re": nrm((DEPTH, G, P, H), (2.0 * H) ** -0.5),
        "ssm_b_im": nrm((DEPTH, G, P, H), (2.0 * H) ** -0.5),
        "ssm_c_re": nrm((DEPTH, G, H, P), (2.0 * P) ** -0.5),
        "ssm_c_im": nrm((DEPTH, G, H, P), (2.0 * P) ** -0.5),
        "ssm_d": nrm((DEPTH, SSM_WIDTH), 1.0),
        "ssm_glu_w": nrm((DEPTH, SSM_WIDTH, SSM_WIDTH), SSM_WIDTH ** -0.5),
        "ssm_glu_b": nrm((DEPTH, SSM_WIDTH), 0.01),
        "ssm_norm_w": 1.0 + nrm((DEPTH, SSM_WIDTH), 0.02),
        "ret_gn_w": 1.0 + nrm((DEPTH, RET_WIDTH), 0.02),
        "ret_gn_b": nrm((DEPTH, RET_WIDTH), 0.01),
        "sb_norm_w": 1.0 + nrm((DEPTH, SB_WIDTH), 0.02),
        "w_out": nrm((DEPTH, MIX_WIDTH, D_MODEL), MIX_WIDTH ** -0.5 * BETA_INIT),
        "ln_mix_w": 1.0 + nrm((DEPTH, D_MODEL), 0.02),
        "ln_mix_b": nrm((DEPTH, D_MODEL), 0.01),
        "ffn_w_gate": nrm((N_DENSE, D_MODEL, D_FF), d_in),
        "ffn_w_up": nrm((N_DENSE, D_MODEL, D_FF), d_in),
        "ffn_w_down": nrm((N_DENSE, D_FF, D_MODEL), D_FF ** -0.5 * BETA_INIT),
        "moe_router": nrm((N_MOE, D_MODEL, N_EXPERTS), d_in),
        "moe_w_gate": nrm((N_MOE, N_EXPERTS, D_MODEL, D_FF_EXPERT), d_in),
        "moe_w_up": nrm((N_MOE, N_EXPERTS, D_MODEL, D_FF_EXPERT), d_in),
        "moe_w_down": nrm((N_MOE, N_EXPERTS, D_FF_EXPERT, D_MODEL), D_FF_EXPERT ** -0.5 * BETA_INIT),
        "ln_ffn_w": 1.0 + nrm((DEPTH, D_MODEL), 0.02),
        "ln_ffn_b": nrm((DEPTH, D_MODEL), 0.01),
    }


def reference(x, w_in, ssm_lam_re, ssm_lam_im, ssm_log_dt, ssm_b_re, ssm_b_im, ssm_c_re, ssm_c_im,
              ssm_d, ssm_glu_w, ssm_glu_b, ssm_norm_w, ret_gn_w, ret_gn_b, sb_norm_w, w_out,
              ln_mix_w, ln_mix_b, ffn_w_gate, ffn_w_up, ffn_w_down, moe_router, moe_w_gate,
              moe_w_up, moe_w_down, ln_ffn_w, ln_ffn_b):
    sizes = (SSM_WIDTH,) + (RET_WIDTH,) * 4 + (SB_WIDTH,) * 3
    split_points = np.cumsum(sizes)[:-1].tolist()
    for layer in range(DEPTH):
        proj = x @ w_in[layer]
        u, rq, rk, rv, rg, sq, sk, sv = jnp.split(proj, split_points, axis=-1)
        y_ssm = s5_mixer(u, ssm_lam_re[layer], ssm_lam_im[layer], ssm_log_dt[layer],
                         ssm_b_re[layer], ssm_b_im[layer], ssm_c_re[layer], ssm_c_im[layer],
                         ssm_d[layer], ssm_glu_w[layer], ssm_glu_b[layer], ssm_norm_w[layer])
        y_ret = retention_mixer(rq, rk, rv, rg, ret_gn_w[layer], ret_gn_b[layer])
        y_sb = stick_breaking_mixer(sq, sk, sv, sb_norm_w[layer])
        mix = jnp.concatenate([y_ssm, y_ret, y_sb], axis=-1) @ w_out[layer]
        x = layer_norm(ALPHA * x + mix, ln_mix_w[layer], ln_mix_b[layer])
        li = layer // 2
        if layer % 2 == 0:
            f = swiglu(x, ffn_w_gate[li], ffn_w_up[li], ffn_w_down[li])
        else:
            f = moe_swiglu(x, moe_router[li], moe_w_gate[li], moe_w_up[li], moe_w_down[li])
        x = layer_norm(ALPHA * x + f, ln_ffn_w[layer], ln_ffn_b[layer])
    return x
```

```cpp
#include <hip/hip_runtime.h>
#include <cstdio>
#include <cstdint>
namespace pg8 {
#define PG8_LAS __attribute__((address_space(3)))
typedef unsigned short bf16_t;
typedef short bf16x8 __attribute__((ext_vector_type(8)));
typedef float f32x4 __attribute__((ext_vector_type(4)));
typedef unsigned u32x4 __attribute__((ext_vector_type(4)));
constexpr int BM = 256, BK = 64, HALF = 128, HTB = HALF * BK * 2  , STAGE_BYTES = 8 * HTB, NXCD = 8, WGM = 8;

__host__ __device__ __forceinline__ int lds_byte(int r, int c) { const int st = (r >> 4) * 2 + (c >> 5), rr = r & 15, cc = c & 31, ob = rr * 64 + cc * 2; return st * 1024 + (ob ^ (((ob >> 9) & 1) << 5)); }
__host__ __device__ __forceinline__ void stage_rc(int b, int& R, int& C) { const int st = b / 1024, sb = b % 1024, swz = sb ^ (((sb >> 9) & 1) << 5); R = (st >> 1) * 16 + swz / 64; C = (st & 1) * 32 + (swz % 64) / 2; }
__host__ __device__ __forceinline__ int perm32(int rho) { const int n = rho >> 4, i = rho & 15; return 8 * (i >> 2) + 4 * n + (i & 3); }

struct Unit { int pm, pn, pb; };
struct Gemm { const bf16_t* A; const bf16_t* Bt; int M, N, K; };

struct StaticOrder {
    int nM, nN, nwg, G, c;
    __host__ __device__ void init(int M, int N, int G_, int c_) { nM = M / BM; nN = N / BM; nwg = nM * nN; G = G_; c = c_; }
    __host__ __device__ bool next(int i, Unit& u) const {
        const long L = (long)i * G + c; if (L >= nwg) return false;
        int wgid = (int)L; { const int q = nwg / NXCD, r = nwg % NXCD, xcd = wgid % NXCD, off = wgid / NXCD; wgid = (xcd < r ? xcd * (q + 1) : r * (q + 1) + (xcd - r) * q) + off; }
        const int nig = WGM * nN, gid = wgid / nig, fm = gid * WGM, gsz = (nM - fm) < WGM ? (nM - fm) : WGM;
        u.pm = fm + ((wgid % nig) % gsz); u.pn = (wgid % nig) / gsz; u.pb = u.pn; return true;
    }
    __device__ __forceinline__ void a_ready(const Unit&) const {}
    __device__ __forceinline__ void done(const Unit&) const {}
};

__device__ __forceinline__ unsigned cvt_pk_bf16(float lo, float hi) { unsigned r; asm volatile("v_cvt_pk_bf16_f32 %0, %1, %2" : "=v"(r) : "v"(lo), "v"(hi)); return r; }
typedef float f32x2 __attribute__((ext_vector_type(2)));
__device__ __forceinline__ f32x2 gelu_pk(f32x2 v) {
    const f32x2 av = __builtin_elementwise_abs(v), d = av * 0.2316418882f + 1.0f;
    f32x2 t; t.x = __builtin_amdgcn_rcpf(d.x); t.y = __builtin_amdgcn_rcpf(d.y);
    f32x2 q = t * 0.5307027145f + (-0.7265760135f); q = q * t + 0.7107068705f; q = q * t + (-0.142248368f); q = q * t + 0.127414796f; q = q * t;
    const f32x2 s = (v * v) * (-0.72134752044f);
    f32x2 e; e.x = __builtin_amdgcn_exp2f(s.x); e.y = __builtin_amdgcn_exp2f(s.y);
    const f32x2 m = v * (q * e), r = v - m;
    f32x2 o; o.x = v.x < 0.f ? m.x : r.x; o.y = v.y < 0.f ? m.y : r.y; return o;
}

__device__ __forceinline__ float fast_silu(float x) { return x * __builtin_amdgcn_rcpf(1.0f + __expf(-x)); }
__device__ __forceinline__ float bf2f(unsigned short b) { return __uint_as_float(((unsigned)b) << 16); }

struct EpiStoreBf16 {
    static constexpr bool PERM = true, AFTER_DRAIN = false;
    bf16_t* O; int ldc;
    __device__ __forceinline__ void operator()(const f32x4 (&acc)[2][2][4][2], const Unit& u, int wr, int wc, int fr, int fq) const {
        const int row0 = u.pm * BM + wr * 64 + fr, col0 = u.pn * BM + wc * 32 + 8 * fq;
#pragma unroll
        for (int ai = 0; ai < 2; ++ai)
#pragma unroll
            for (int m = 0; m < 4; ++m) { bf16_t* rowp = O + (size_t)(row0 + ai * HALF + m * 16) * ldc + col0;
#pragma unroll
                for (int bj = 0; bj < 2; ++bj) { const f32x4 v0 = acc[ai][bj][m][0], v1 = acc[ai][bj][m][1];
                    u32x4 w; w.x = cvt_pk_bf16(v0[0], v0[1]); w.y = cvt_pk_bf16(v0[2], v0[3]); w.z = cvt_pk_bf16(v1[0], v1[1]); w.w = cvt_pk_bf16(v1[2], v1[3]);
                    *(u32x4*)(rowp + bj * HALF) = w; } }
    }
};
struct EpiResF32 {
    static constexpr bool PERM = false, AFTER_DRAIN = false;
    const float* src; float* dst; int ldc; float alpha;
    __device__ __forceinline__ void operator()(const f32x4 (&acc)[2][2][4][2], const Unit& u, int wr, int wc, int fr, int fq) const {
        const int row0 = u.pm * BM + wr * 64 + fr, col0 = u.pn * BM + wc * 32 + 4 * fq;
#pragma unroll
        for (int ai = 0; ai < 2; ++ai)
#pragma unroll
            for (int m = 0; m < 4; ++m) { const size_t ro = (size_t)(row0 + ai * HALF + m * 16) * ldc + col0;
#pragma unroll
                for (int bj = 0; bj < 2; ++bj)
#pragma unroll
                    for (int n = 0; n < 2; ++n) { const f32x4 s = *(const f32x4*)(src + ro + bj * HALF + n * 16); *(f32x4*)(dst + ro + bj * HALF + n * 16) = s * alpha + acc[ai][bj][m][n]; } }
    }
};
template <bool ROWW> struct EpiSwiGLU {
    static constexpr bool PERM = true, AFTER_DRAIN = false;
    bf16_t* H; int ldh; const float* roww;
    __device__ __forceinline__ void operator()(const f32x4 (&acc)[2][2][4][2], const Unit& u, int wr, int wc, int fr, int fq) const {
        const int row0 = u.pm * BM + wr * 64 + fr, col0 = u.pn * HALF + wc * 32 + 8 * fq;
#pragma unroll
        for (int ai = 0; ai < 2; ++ai)
#pragma unroll
            for (int m = 0; m < 4; ++m) { const int row = row0 + ai * HALF + m * 16; const float rw = ROWW ? roww[row] : 1.0f;
                float h[8];
#pragma unroll
                for (int n = 0; n < 2; ++n)
#pragma unroll
                    for (int j = 0; j < 4; ++j) h[4 * n + j] = fast_silu(acc[ai][0][m][n][j]) * acc[ai][1][m][n][j] * rw;
                u32x4 w; w.x = cvt_pk_bf16(h[0], h[1]); w.y = cvt_pk_bf16(h[2], h[3]); w.z = cvt_pk_bf16(h[4], h[5]); w.w = cvt_pk_bf16(h[6], h[7]);
                *(u32x4*)(H + (size_t)row * ldh + col0) = w; }
    }
};
struct EpiGLU {
    static constexpr bool PERM = true, AFTER_DRAIN = false;
    const bf16_t* G; const float* glu_b; const float* norm_w; bf16_t* Y; int ldy; float eps;
    __device__ __forceinline__ void operator()(const f32x4 (&acc)[2][2][4][2], const Unit& u, int wr, int wc, int fr, int fq) const {
        const int row0 = u.pm * BM + wr * 64 + fr, col0 = wc * 32 + 8 * fq;
        const bf16_t* G = this->G; const float* glu_b = this->glu_b; const float* norm_w = this->norm_w; bf16_t* Y = this->Y;
        asm volatile("" : "+s"(G), "+s"(glu_b), "+s"(norm_w), "+s"(Y));
#pragma unroll
        for (int bj = 0; bj < 2; ++bj) { const int col = col0 + bj * HALF;
            const f32x4 b0 = *(const f32x4*)(glu_b + col), b1 = *(const f32x4*)(glu_b + col + 4), n0 = *(const f32x4*)(norm_w + col), n1 = *(const f32x4*)(norm_w + col + 4);
#pragma unroll
            for (int ai = 0; ai < 2; ++ai)
#pragma unroll
                for (int m = 0; m < 4; ++m) { const int row = row0 + ai * HALF + m * 16;
                    const u32x4 gr = *(const u32x4*)(G + (size_t)row * 256 + col);
                    float gv[8]; gv[0] = __uint_as_float(gr.x << 16); gv[1] = __uint_as_float(gr.x & 0xffff0000u); gv[2] = __uint_as_float(gr.y << 16); gv[3] = __uint_as_float(gr.y & 0xffff0000u);
                    gv[4] = __uint_as_float(gr.z << 16); gv[5] = __uint_as_float(gr.z & 0xffff0000u); gv[6] = __uint_as_float(gr.w << 16); gv[7] = __uint_as_float(gr.w & 0xffff0000u);
                    float o[8]; float ss = 0.f;
#pragma unroll
                    for (int j = 0; j < 4; ++j) { const float z0 = acc[ai][bj][m][0][j] + b0[j], z1 = acc[ai][bj][m][1][j] + b1[j];
                        o[j] = gv[j] * __builtin_amdgcn_rcpf(1.0f + __expf(-z0)); o[4 + j] = gv[4 + j] * __builtin_amdgcn_rcpf(1.0f + __expf(-z1)); ss += o[j] * o[j] + o[4 + j] * o[4 + j]; }
                    ss += __shfl_xor(ss, 16);
                    const float r = __builtin_amdgcn_rsqf(ss * (1.0f / 16.0f) + eps);
                    u32x4 w; w.x = cvt_pk_bf16(o[0] * r * n0[0], o[1] * r * n0[1]); w.y = cvt_pk_bf16(o[2] * r * n0[2], o[3] * r * n0[3]);
                    w.z = cvt_pk_bf16(o[4] * r * n1[0], o[5] * r * n1[1]); w.w = cvt_pk_bf16(o[6] * r * n1[2], o[7] * r * n1[3]);
                    *(u32x4*)(Y + (size_t)row * ldy + col) = w; asm volatile("" ::: "memory"); } }
    }
};
struct MoeOrder {
    const int* panel_exp; int NT, nunits, G, c;
    __device__ __forceinline__ bool next(int i, Unit& u) const {
        const int L = i * G + c; if (L >= nunits) return false;
        const int p = L / NT, t = L - p * NT; u.pm = p; u.pn = t; u.pb = __builtin_amdgcn_readfirstlane(panel_exp[p]) * NT + t; return true;
    }
    __device__ __forceinline__ void a_ready(const Unit&) const {}
    __device__ __forceinline__ void done(const Unit&) const {}
};

template <class Epi, class Sched, bool ALIGN_EPI = false, bool SP2 = false>
__device__ __forceinline__ void gemm_phase(PG8_LAS unsigned char* lds, const Gemm g, const Sched& S, const Epi& E) {
    int tid_o = threadIdx.x; asm volatile("" : "+v"(tid_o));
    const int tid = tid_o, wid = __builtin_amdgcn_readfirstlane(tid >> 6), lane = tid & 63, wr = wid >> 2, wc = wid & 3, fr = lane & 15, fq = lane >> 4;
    const int K = g.K, nt = K / BK;
    unsigned voffA[2], voffB[2];
#pragma unroll
    for (int i = 0; i < 2; ++i) { int R, C; stage_rc(tid * 16 + i * 8192, R, C); const int Rb = Epi::PERM ? ((R & ~31) + perm32(R & 31)) : R;
        voffA[i] = (unsigned)(R * K + C) * 2u; voffB[i] = (unsigned)(Rb * K + C) * 2u; }
    const size_t kstep = (size_t)(BK * 2);
    const size_t hstep = (size_t)HALF * K * 2;
    const size_t tstep = 2 * hstep;
    const unsigned ldsw = (unsigned)wid * 1024u;
    const int aoff = lds_byte(wr * 64 + fr, fq * 8), boff = lds_byte(wc * 32 + fr, fq * 8);
#define PG8_SA(b, h) (((b) * 2 + (h)) * HTB)
#define PG8_SB(b, h) ((4 + (b) * 2 + (h)) * HTB)
#define PG8_STAGE(bufoff, gbase, voff) do { _Pragma("unroll") for (int _i = 0; _i < 2; ++_i) \
        __builtin_amdgcn_global_load_lds((const unsigned*)((const char*)(gbase) + (voff)[_i]), (PG8_LAS unsigned*)(lds + (bufoff) + ldsw + _i * 8192), 16, 0, 0); } while (0)
#define PG8_LDA(dst, b, h) do { _Pragma("unroll") for (int m = 0; m < 4; ++m) _Pragma("unroll") for (int k = 0; k < 2; ++k) dst[m][k] = *(const PG8_LAS bf16x8*)(lds + PG8_SA(b, h) + aoff + m * 2048 + k * 1024); } while (0)
#define PG8_LDB(dst, b, h) do { _Pragma("unroll") for (int n = 0; n < 2; ++n) _Pragma("unroll") for (int k = 0; k < 2; ++k) dst[n][k] = *(const PG8_LAS bf16x8*)(lds + PG8_SB(b, h) + boff + n * 2048 + k * 1024); } while (0)
#define PG8_MMA(ai, bj, At, Bt) do { __builtin_amdgcn_s_setprio(1); _Pragma("unroll") for (int m = 0; m < 4; ++m) _Pragma("unroll") for (int n = 0; n < 2; ++n) _Pragma("unroll") for (int k = 0; k < 2; ++k) \
        acc[ai][bj][m][n] = __builtin_amdgcn_mfma_f32_16x16x32_bf16(Bt[n][k], At[m][k], acc[ai][bj][m][n], 0, 0, 0); __builtin_amdgcn_s_setprio(0); } while (0)
#define PG8_WAIT_V(n) asm volatile("s_waitcnt vmcnt(" #n ")" ::: "memory")
#define PG8_WAIT_L(n) asm volatile("s_waitcnt lgkmcnt(" #n ")" ::: "memory")
#define PG8_BAR __builtin_amdgcn_s_barrier()
#define PG8_SCHED __builtin_amdgcn_sched_barrier(0)
    Unit cur, nxt; int ui = 0;
    if (!S.next(0, cur)) return;
    f32x4 acc[2][2][4][2];
#pragma unroll
    for (int a = 0; a < 2; ++a)
#pragma unroll
        for (int b = 0; b < 2; ++b)
#pragma unroll
            for (int m = 0; m < 4; ++m)
#pragma unroll
                for (int n = 0; n < 2; ++n) acc[a][b][m][n] = (f32x4){0.f, 0.f, 0.f, 0.f};
    bf16x8 At[4][2], B0[2][2], B1[2][2];
    const char* cA = (const char*)g.A + (size_t)cur.pm * tstep; const char* cB = (const char*)g.Bt + (size_t)cur.pb * tstep;
    S.a_ready(cur);
    if constexpr (SP2) {
        PG8_STAGE(PG8_SB(0, 0), cB, voffB); PG8_STAGE(PG8_SB(0, 1), cB + hstep, voffB); PG8_STAGE(PG8_SA(0, 0), cA, voffA); PG8_STAGE(PG8_SA(0, 1), cA + hstep, voffA);
        if (wr == 1) PG8_BAR;
        PG8_WAIT_V(2); PG8_BAR;
        PG8_STAGE(PG8_SB(1, 0), cB + kstep, voffB); PG8_STAGE(PG8_SA(1, 0), cA + kstep, voffA); PG8_STAGE(PG8_SB(1, 1), cB + hstep + kstep, voffB);
        PG8_WAIT_V(6); PG8_BAR;
    } else {
        PG8_STAGE(PG8_SB(0, 0), cB, voffB); PG8_STAGE(PG8_SA(0, 0), cA, voffA); PG8_STAGE(PG8_SB(0, 1), cB + hstep, voffB); PG8_STAGE(PG8_SA(0, 1), cA + hstep, voffA);
        if (wr == 1) PG8_BAR;
        PG8_WAIT_V(4); PG8_BAR;
        PG8_STAGE(PG8_SB(1, 0), cB + kstep, voffB); PG8_STAGE(PG8_SA(1, 0), cA + kstep, voffA); PG8_STAGE(PG8_SB(1, 1), cB + hstep + kstep, voffB);
        PG8_WAIT_V(6); PG8_BAR;
    }
    for (;;) {
        const bool has_next = S.next(ui + 1, nxt);
        const char* nA = has_next ? (const char*)g.A + (size_t)nxt.pm * tstep : cA; const char* nB = has_next ? (const char*)g.Bt + (size_t)nxt.pb * tstep : cB;
        for (int t = 0; t < nt; t += 2) {
            const bool last = (t == nt - 2);
            const char* a1 = cA + (size_t)(t + 1) * kstep;
            const char* a2 = last ? nA : cA + (size_t)(t + 2) * kstep; const char* b2 = last ? nB : cB + (size_t)(t + 2) * kstep;
            const char* a3 = a2 + kstep; const char* b3 = b2 + kstep;
            if (last && has_next) S.a_ready(nxt);
            if constexpr (SP2) {
            PG8_LDB(B0, 0, 0); PG8_LDB(B1, 0, 1); PG8_SCHED; PG8_LDA(At, 0, 0); PG8_STAGE(PG8_SA(1, 1), a1 + hstep, voffA);
            PG8_WAIT_V(8); PG8_WAIT_L(0); PG8_BAR; PG8_MMA(0, 0, At, B0); PG8_MMA(0, 1, At, B1); PG8_BAR; PG8_SCHED;
            PG8_LDA(At, 0, 1); PG8_STAGE(PG8_SB(0, 0), b2, voffB); PG8_STAGE(PG8_SB(0, 1), b2 + hstep, voffB); PG8_STAGE(PG8_SA(0, 0), a2, voffA);
            PG8_WAIT_V(8); PG8_WAIT_L(0); PG8_BAR; PG8_MMA(1, 0, At, B0); PG8_MMA(1, 1, At, B1); PG8_BAR; PG8_SCHED;
            PG8_LDB(B0, 1, 0); PG8_LDB(B1, 1, 1); PG8_SCHED; PG8_LDA(At, 1, 0); PG8_STAGE(PG8_SA(0, 1), a2 + hstep, voffA);
            PG8_WAIT_V(8); PG8_WAIT_L(0); PG8_BAR; PG8_MMA(0, 0, At, B0); PG8_MMA(0, 1, At, B1); PG8_BAR; PG8_SCHED;
            PG8_LDA(At, 1, 1); PG8_STAGE(PG8_SB(1, 0), b3, voffB); PG8_STAGE(PG8_SB(1, 1), b3 + hstep, voffB); PG8_STAGE(PG8_SA(1, 0), a3, voffA);
            PG8_WAIT_V(8); PG8_WAIT_L(0); PG8_BAR; PG8_MMA(1, 0, At, B0); PG8_MMA(1, 1, At, B1); PG8_BAR; PG8_SCHED;
            } else {
            PG8_LDB(B0, 0, 0); PG8_SCHED; PG8_LDA(At, 0, 0); PG8_STAGE(PG8_SA(1, 1), a1 + hstep, voffA);
            PG8_WAIT_L(8); PG8_BAR; PG8_WAIT_L(0); PG8_MMA(0, 0, At, B0); PG8_BAR; PG8_SCHED;
            PG8_LDB(B1, 0, 1); PG8_STAGE(PG8_SB(0, 0), b2, voffB);
            PG8_BAR; PG8_WAIT_L(0); PG8_MMA(0, 1, At, B1); PG8_BAR;
            PG8_LDA(At, 0, 1); PG8_STAGE(PG8_SA(0, 0), a2, voffA);
            PG8_BAR; PG8_WAIT_L(0); PG8_MMA(1, 0, At, B0); PG8_BAR; PG8_SCHED;
            PG8_STAGE(PG8_SB(0, 1), b2 + hstep, voffB);
            PG8_WAIT_V(6); PG8_BAR; PG8_MMA(1, 1, At, B1); PG8_BAR;
            PG8_LDB(B0, 1, 0); PG8_SCHED; PG8_LDA(At, 1, 0); PG8_STAGE(PG8_SA(0, 1), a2 + hstep, voffA);
            PG8_WAIT_L(8); PG8_BAR; PG8_WAIT_L(0); PG8_MMA(0, 0, At, B0); PG8_BAR; PG8_SCHED;
            PG8_LDB(B1, 1, 1); PG8_STAGE(PG8_SB(1, 0), b3, voffB);
            PG8_BAR; PG8_WAIT_L(0); PG8_MMA(0, 1, At, B1); PG8_BAR;
            PG8_LDA(At, 1, 1); PG8_STAGE(PG8_SA(1, 0), a3, voffA);
            PG8_BAR; PG8_WAIT_L(0); PG8_MMA(1, 0, At, B0); PG8_BAR; PG8_SCHED;
            PG8_STAGE(PG8_SB(1, 1), b3 + hstep, voffB);
            PG8_WAIT_V(6); PG8_BAR; PG8_MMA(1, 1, At, B1); PG8_BAR;
            }
        }
        if constexpr (ALIGN_EPI) { if (wr == 0) PG8_BAR; }
        if constexpr (!Epi::AFTER_DRAIN) { E(acc, cur, wr, wc, fr, fq); S.done(cur); }
        if (!has_next) break;
#pragma unroll
        for (int a = 0; a < 2; ++a)
#pragma unroll
            for (int b = 0; b < 2; ++b)
#pragma unroll
                for (int m = 0; m < 4; ++m)
#pragma unroll
                    for (int n = 0; n < 2; ++n) acc[a][b][m][n] = (f32x4){0.f, 0.f, 0.f, 0.f};
        cur = nxt; cA = nA; cB = nB; ++ui;
        if constexpr (ALIGN_EPI) { if (wr == 1) PG8_BAR; }
    }
    PG8_WAIT_V(0);
    if constexpr (!ALIGN_EPI) { if (wr == 0) PG8_BAR; }
    PG8_BAR;
    if constexpr (Epi::AFTER_DRAIN) { E.fused(acc, cur, wr, wc, fr, fq, lds, wid, lane); S.done(cur); }
#undef PG8_SA
#undef PG8_SB
#undef PG8_STAGE
#undef PG8_LDA
#undef PG8_LDB
#undef PG8_MMA
#undef PG8_WAIT_V
#undef PG8_WAIT_L
#undef PG8_BAR
#undef PG8_SCHED
}
}
#define PG8_SP2 true
#define PG8_ALIGN true

constexpr int BATCH = 2, SEQ = 16384, T = BATCH * SEQ, D = 1024, DEPTH = 4;
constexpr int NPROJ = 2304, NVT = 768;
constexpr int PC_U = 0, PC_RQ = 256, PC_RK = 768, PC_RG = 1280, PC_SQ = 1792, PC_SK = 2048, VT_RV = 0, VT_SV = 512;
constexpr int DFF = 2752, DFFP = 2816, EFF = 688, EFFP = 768, NE = 8;
constexpr int CH = 128, NUC = T / CH;
constexpr int MAXPAN = 264, MAXROWS = MAXPAN * 256;
constexpr float ALPHA = 1.6817928305074290f, LN_EPS = 1e-5f;
constexpr float SB_THR = 30.0f;

constexpr size_t MiB = 1u << 20;
constexpr size_t WS_CTL = 0, CTL_ZERO_BYTES = 1 * MiB;
constexpr size_t WS_WIN = 1 * MiB, WS_WOUT = 25 * MiB, WS_FGU = 33 * MiB, WS_FDN = 55 * MiB, WS_MGU = 66 * MiB, WS_MDN = 114 * MiB, WS_GLU = 138 * MiB;
constexpr size_t WS_ROPE = 139 * MiB;
constexpr size_t WS_S5LOC = 143 * MiB, WS_S5CAR = 145 * MiB;
constexpr size_t WS_MOE = 147 * MiB;
constexpr size_t MO_S5TAB = 1792 * 1024, MO_RETLG = 1920 * 1024;
constexpr size_t MO_SELE = 0, MO_SELR = 128 * 1024, MO_SELW = 256 * 1024, MO_TOKPOS = 512 * 1024, MO_ROWW = 768 * 1024, MO_COUNTS = 1280 * 1024, MO_PANEL = 1536 * 1024;
constexpr size_t WS_R1 = 149 * MiB;
constexpr size_t WS_VT = WS_R1 + 144 * MiB;
constexpr size_t WS_R2 = 341 * MiB;
constexpr size_t WS_RETLOC = WS_R2, WS_RETPREV = WS_R2 + 32 * MiB, WS_GBUF = WS_R2 + 48 * MiB;
constexpr size_t WS_R3 = 405 * MiB;
constexpr size_t WS_END = 469 * MiB;
static_assert((size_t)MAXROWS * EFFP * 2 <= 128 * MiB && (size_t)MAXROWS * 1024 * 2 <= 192 * MiB && (size_t)T * DFFP * 2 <= 192 * MiB, "overlay sizes");
constexpr int CW_TMO = 0, CW_NP = 64, CW_BAR = 4096;

constexpr int RING_OFF = 0, RING_BYTES = 131072;
constexpr int LDSCTL_OFF = RING_BYTES, MISC_OFF = LDSCTL_OFF + 320;
constexpr int LDS_BYTES = 147456;
constexpr int NWAVES = 8;

#define GAS __attribute__((address_space(1)))
#define LAS __attribute__((address_space(3)))
typedef unsigned short bf16;
typedef unsigned u32x4 __attribute__((ext_vector_type(4)));
typedef unsigned u32x2 __attribute__((ext_vector_type(2)));
typedef float f32x4 __attribute__((ext_vector_type(4)));
typedef float f32x2 __attribute__((ext_vector_type(2)));
typedef float f32x16 __attribute__((ext_vector_type(16)));
typedef short bf16x8 __attribute__((ext_vector_type(8)));
typedef GAS unsigned gu32;
#define RLX_AGENT __ATOMIC_RELAXED, __HIP_MEMORY_SCOPE_AGENT
#define LDS_WAIT() asm volatile("s_waitcnt lgkmcnt(0)" ::: "memory")
#define VM_WAIT() asm volatile("s_waitcnt vmcnt(0)" ::: "memory")

#define XB_TMO      128
#define XB_XCNT(j)  (256  + 64 * (j))
#define XB_XSUB(j)  (1280 + 64 * (j))
#define XB_XGEN(j)  (2304 + 64 * (j))
#define XB_TOP      3328
#define XB_TOPGEN   3392
#define XCD_BAR_WORDS 3456
#define XB_SPIN_CAP (1u << 18)

__device__ __forceinline__ unsigned xb_ld(unsigned* p)              { return __hip_atomic_load(p, __ATOMIC_RELAXED, __HIP_MEMORY_SCOPE_AGENT); }
__device__ __forceinline__ unsigned xb_add(unsigned* p, unsigned v) { return __hip_atomic_fetch_add(p, v, __ATOMIC_RELAXED, __HIP_MEMORY_SCOPE_AGENT); }
__device__ __forceinline__ unsigned xb_xcc_id() { return (unsigned)__builtin_amdgcn_s_getreg((3 << 11) | 20) & 0xFu; }
#define XB_SPIN(cond, bar) do { unsigned _sp = 0; while (cond) { __builtin_amdgcn_s_sleep(1); \
    if ((++_sp & 255u) == 0u) { if (xb_ld(&(bar)[XB_TMO])) break; if (_sp > XB_SPIN_CAP) { atomicAdd(&(bar)[XB_TMO], 1u); break; } } } } while (0)

struct XcdBarrier {
    unsigned* bar; unsigned x;
    volatile LAS unsigned* st;
};

__device__ __forceinline__ XcdBarrier xcd_barrier_post(unsigned* bar, volatile LAS unsigned* st) {
    XcdBarrier b; b.bar = bar; b.x = xb_xcc_id(); b.st = st;
    if (threadIdx.x == 0) (void)xb_add(&bar[XB_XCNT(b.x)], 1u);
    return b;
}
__device__ __forceinline__ void xcd_barrier_complete(unsigned* bar, unsigned x, unsigned& nloc, unsigned& nx) {
    const unsigned G = gridDim.x * gridDim.y * gridDim.z;
    unsigned sum, cnt, mine, sp = 0u;
    for (;;) {
        sum = 0u; cnt = 0u; mine = 0u;
#pragma unroll
        for (unsigned j = 0; j < 16; ++j) { const unsigned c = xb_ld(&bar[XB_XCNT(j)]); sum += c; cnt += (c > 0u) ? 1u : 0u; mine = (j == x) ? c : mine; }
        if (sum == G) break;
        __builtin_amdgcn_s_sleep(1);
        if ((++sp & 255u) == 0u) { if (xb_ld(&bar[XB_TMO])) break; if (sp > XB_SPIN_CAP) { atomicAdd(&bar[XB_TMO], 1u); break; } }
    }
    nloc = mine > 0u ? mine : 1u; nx = cnt > 0u ? cnt : 1u;
}

__device__ __forceinline__ void xcd_barrier(const XcdBarrier& b) {
    asm volatile("s_waitcnt vmcnt(0)" ::: "memory");
    __syncthreads();
    if (threadIdx.x == 0) {
        unsigned* bar = b.bar; asm volatile("" : "+s"(bar));
        __builtin_amdgcn_s_waitcnt(0);
        unsigned nloc = b.st[0], nx = b.st[1];
        if (nloc == 0u) { xcd_barrier_complete(bar, b.x, nloc, nx); b.st[0] = nloc; b.st[1] = nx; }
        const unsigned old = xb_add(&bar[XB_XSUB(b.x)], 1u);
        const unsigned gen = old / nloc;
        if (old + 1u == (gen + 1u) * nloc) {
            __builtin_amdgcn_fence(__ATOMIC_RELEASE, "agent");
            asm volatile("s_waitcnt vmcnt(0)" ::: "memory");
            const unsigned og = xb_add(&bar[XB_TOP], 1u);
            const unsigned tg = og / nx;
            if (og + 1u == (tg + 1u) * nx) xb_add(&bar[XB_TOPGEN], 1u);
            else XB_SPIN(xb_ld(&bar[XB_TOPGEN]) == tg, bar);
            __builtin_amdgcn_fence(__ATOMIC_ACQUIRE, "agent");
            xb_add(&bar[XB_XGEN(b.x)], 1u);
            asm volatile("s_waitcnt vmcnt(0)" ::: "memory");
        } else {
            XB_SPIN(xb_ld(&bar[XB_XGEN(b.x)]) == gen, bar);
            __builtin_amdgcn_fence(__ATOMIC_ACQUIRE, "agent");
            asm volatile("s_waitcnt vmcnt(0)" ::: "memory");
        }
    }
    __syncthreads();
}

__device__ __forceinline__ float bf2f(unsigned short b) { return __uint_as_float(((unsigned)b) << 16); }
__device__ __forceinline__ unsigned cvtpk(float lo, float hi) { return pg8::cvt_pk_bf16(lo, hi); }
__device__ __forceinline__ float wave_sum(float v) {
#pragma unroll
    for (int o = 1; o < 64; o <<= 1) v += __shfl_xor(v, o);
    return v;
}
__device__ __forceinline__ int wave_sum_i(int v) {
#pragma unroll
    for (int o = 1; o < 64; o <<= 1) v += __shfl_xor(v, o);
    return v;
}
__device__ __forceinline__ bf16x8 ld8(const bf16* p) { return __builtin_bit_cast(bf16x8, *(const u32x4*)p); }
__device__ __forceinline__ bf16x8 pack8(const float* a) { u32x4 w; w.x = cvtpk(a[0], a[1]); w.y = cvtpk(a[2], a[3]); w.z = cvtpk(a[4], a[5]); w.w = cvtpk(a[6], a[7]); return __builtin_bit_cast(bf16x8, w); }
__device__ __forceinline__ void unpack8(const u32x4 r, float* o) {
    o[0] = __uint_as_float(r.x << 16); o[1] = __uint_as_float(r.x & 0xffff0000u); o[2] = __uint_as_float(r.y << 16); o[3] = __uint_as_float(r.y & 0xffff0000u);
    o[4] = __uint_as_float(r.z << 16); o[5] = __uint_as_float(r.z & 0xffff0000u); o[6] = __uint_as_float(r.w << 16); o[7] = __uint_as_float(r.w & 0xffff0000u);
}
__device__ __forceinline__ int tau(int r) { return 16 * ((r >> 2) & 1) + 4 * (r >> 3) + (r & 3); }
#define MFMA32(a, b, c) __builtin_amdgcn_mfma_f32_32x32x16_bf16(a, b, c, 0, 0, 0)
#define MFMA16(a, b, c) __builtin_amdgcn_mfma_f32_16x16x32_bf16(a, b, c, 0, 0, 0)
__device__ __forceinline__ float gelu_tanh(float x) {
    const float a = 0.7978845608028654f * (x + 0.044715f * x * x * x);
    const float th = 1.0f - 2.0f * __builtin_amdgcn_rcpf(1.0f + __expf(2.0f * a));
    return 0.5f * x * (1.0f + th);
}

struct Args { const float* in[28]; float* out; unsigned char* ws; };
typedef const __attribute__((address_space(4))) Args* ArgsP;
enum { I_X = 0, I_WIN, I_LAMRE, I_LAMIM, I_LOGDT, I_BRE, I_BIM, I_CRE, I_CIM, I_SSMD, I_GLUW, I_GLUB, I_SSMNW, I_RETGW, I_RETGB, I_SBNW, I_WOUT, I_LNMW, I_LNMB,
       I_FG, I_FU, I_FD, I_ROUTER, I_MG, I_MU, I_MD, I_LNFW, I_LNFB };

__device__ __forceinline__ void tr_item(const float* W, int Ks, int Ns, bf16* WT, int Kd, int k0, int n0, int drow0, LAS float* scr, int lane) {
#pragma unroll 8
    for (int i = 0; i < 32; ++i) { const int kk = 2 * i + (lane >> 5), k = k0 + kk, n = n0 + (lane & 31);
        scr[kk * 33 + (lane & 31)] = (k < Ks && n < Ns) ? W[(size_t)k * Ns + n] : 0.f; }
    LDS_WAIT(); asm volatile("" ::: "memory");
    const int c = lane & 7;
#pragma unroll
    for (int j = 0; j < 4; ++j) { const int n = (lane >> 3) + 8 * j; const LAS float* s = scr + (8 * c) * 33 + n;
        u32x4 o; o.x = cvtpk(s[0 * 33], s[1 * 33]); o.y = cvtpk(s[2 * 33], s[3 * 33]); o.z = cvtpk(s[4 * 33], s[5 * 33]); o.w = cvtpk(s[6 * 33], s[7 * 33]);
        *(u32x4*)(WT + (size_t)(drow0 + n) * Kd + k0 + 8 * c) = o; }
    LDS_WAIT(); asm volatile("" ::: "memory");
}
__device__ __forceinline__ void p0_prologue(ArgsP a, LAS unsigned char* lds, int tid, int lane, int wave) {
    unsigned char* ws = a->ws;
    LAS float* scr = (LAS float*)(lds + wave * 16384);
    const int gw = blockIdx.x * NWAVES + wave, NGW = gridDim.x * NWAVES;
    constexpr int NA = 4 * 1536, NB = 4 * 512, NC = 2 * 2816, ND = 2 * 1408, NEE = 16 * 768, NF = 16 * 384, NG = 4 * 32;
    constexpr int NITEMS = NA + NB + NC + ND + NEE + NF + NG;
    for (int it = gw; it < NITEMS; it += NGW) {
        int r = it;
        if (r < NA) { const int l = r / 1536, q = r % 1536, kb = q / 96, nb = q % 96, c = 32 * nb;
            const int drow = c < 1280 ? c : (c < 1792 ? 2304 + (c - 1280) : (c < 2816 ? c - 512 : c));
            tr_item(a->in[I_WIN] + (size_t)l * 1024 * 3072, 1024, 3072, (bf16*)(ws + WS_WIN) + (size_t)l * 3072 * 1024, 1024, 64 * kb, c, drow, scr, lane); continue; }
        r -= NA;
        if (r < NB) { const int l = r / 512, q = r % 512, kb = q / 32, nb = q % 32;
            tr_item(a->in[I_WOUT] + (size_t)l * 1024 * 1024, 1024, 1024, (bf16*)(ws + WS_WOUT) + (size_t)l * 1024 * 1024, 1024, 64 * kb, 32 * nb, 32 * nb, scr, lane); continue; }
        r -= NB;
        if (r < NC) { const int li = r / 2816, q = r % 2816, db = q / 16, kb = q % 16, pn = db >> 3, wi = db & 7, ffc = 128 * pn + 32 * (wi & 3);
            const float* src = (wi >> 2) ? a->in[I_FU] : a->in[I_FG];
            tr_item(src + (size_t)li * 1024 * DFF, 1024, DFF, (bf16*)(ws + WS_FGU) + (size_t)li * 5632 * 1024, 1024, 64 * kb, ffc, 32 * db, scr, lane); continue; }
        r -= NC;
        if (r < ND) { const int li = r / 1408, q = r % 1408, kb = q / 32, nb = q % 32;
            tr_item(a->in[I_FD] + (size_t)li * DFF * 1024, DFF, 1024, (bf16*)(ws + WS_FDN) + (size_t)li * 1024 * DFFP, DFFP, 64 * kb, 32 * nb, 32 * nb, scr, lane); continue; }
        r -= ND;
        if (r < NEE) { const int le = r / 768, q = r % 768, db = q / 16, kb = q % 16, pn = db >> 3, wi = db & 7, ffc = 128 * pn + 32 * (wi & 3);
            const float* src = (wi >> 2) ? a->in[I_MU] : a->in[I_MG];
            tr_item(src + (size_t)le * 1024 * EFF, 1024, EFF, (bf16*)(ws + WS_MGU) + (size_t)le * 1536 * 1024, 1024, 64 * kb, ffc, 32 * db, scr, lane); continue; }
        r -= NEE;
        if (r < NF) { const int le = r / 384, q = r % 384, kb = q / 32, nb = q % 32;
            tr_item(a->in[I_MD] + (size_t)le * EFF * 1024, EFF, 1024, (bf16*)(ws + WS_MDN) + (size_t)le * 1024 * EFFP, EFFP, 64 * kb, 32 * nb, 32 * nb, scr, lane); continue; }
        r -= NF;
        { const int l = r / 32, q = r % 32, kb = q / 8, nb = q % 8;
            tr_item(a->in[I_GLUW] + (size_t)l * 65536, 256, 256, (bf16*)(ws + WS_GLU) + (size_t)l * 65536, 256, 64 * kb, 32 * nb, 32 * nb, scr, lane); }
    }
    { const f32x4* x4 = (const f32x4*)a->in[I_X]; u32x4* o = (u32x4*)(ws + WS_R2);
      const size_t n8 = (size_t)T * D / 8, gt = (size_t)blockIdx.x * (NWAVES * 64) + tid, GT = (size_t)gridDim.x * NWAVES * 64;
      for (size_t i = gt; i < n8; i += GT) { const f32x4 v0 = x4[2 * i], v1 = x4[2 * i + 1]; u32x4 w; w.x = cvtpk(v0[0], v0[1]); w.y = cvtpk(v0[2], v0[3]); w.z = cvtpk(v1[0], v1[1]); w.w = cvtpk(v1[2], v1[3]); o[i] = w; } }
    { float* tab = (float*)(ws + WS_MOE + MO_S5TAB);
      const int gt = blockIdx.x * (NWAVES * 64) + tid, GT = gridDim.x * NWAVES * 64;
      for (int i = gt; i < DEPTH * 16 * 64; i += GT) { const int lg = i >> 6;
          const float lr = a->in[I_LAMRE][i], li = a->in[I_LAMIM][i], dt = expf(a->in[I_LOGDT][lg]);
          const float zr = lr * dt, zi = li * dt; float sn, cs; sincosf(zi, &sn, &cs);
          const float mag = expf(zr), ar = mag * cs, ai = mag * sn;
          const float sh = sinf(0.5f * zi); const float mr = expm1f(zr) * cs - 2.0f * sh * sh, mi = ai;
          const float den = 1.0f / (lr * lr + li * li);
          const float cr = (mr * lr + mi * li) * den, ci = (mi * lr - mr * li) * den;
          const double zr128 = (double)lr * (double)dt * 128.0, zi128 = (double)li * (double)dt * 128.0; const double m128 = exp(zr128);
          f32x4* o = (f32x4*)(tab + (size_t)i * 8); o[0] = (f32x4){ar, ai, cr, ci}; o[1] = (f32x4){(float)(m128 * cos(zi128)), (float)(m128 * sin(zi128)), 0.f, 0.f}; }
      if (gt < 8) ((float*)(ws + WS_MOE + MO_RETLG))[gt] = (float)log2(1.0 - exp2(-5.0 - (double)gt)); }
    { float* ct = (float*)(ws + WS_ROPE); float* st = ct + SEQ * 32;
      const int gt = blockIdx.x * (NWAVES * 64) + tid, GT = gridDim.x * NWAVES * 64;
      for (int i = gt; i < SEQ * 32; i += GT) { const int pos = i >> 5, f = i & 31; const double inv = exp(-(double)f * (9.210340371976184 / 32.0)); const double ang = (double)pos * inv;
          ct[i] = (float)cos(ang); st[i] = (float)sin(ang); } }
}

template <int MODE>
__device__ __forceinline__ void ln_phase(ArgsP a, const float* lnw, const float* lnb, const float* wrouter, LAS unsigned char* lds, int tid, int lane, int wave) {
    unsigned char* ws = a->ws;
    float* out = a->out; bf16* xb = (bf16*)(ws + WS_R2);
    f32x4 wv[4], bv[4];
#pragma unroll
    for (int j = 0; j < 4; ++j) { wv[j] = ((const f32x4*)lnw)[lane + 64 * j]; bv[j] = ((const f32x4*)lnb)[lane + 64 * j]; }
    LAS float* wrs = (LAS float*)lds; LAS int* cnt = (LAS int*)(lds + 32768);
    if (MODE == 1) {
        for (int i = tid; i < 8192; i += NWAVES * 64) { const int c = i >> 3, e = i & 7; wrs[e * 1024 + c] = wrouter[i]; }
        if (tid < 8) cnt[tid] = 0;
        __syncthreads();
    }
    unsigned* selE = (unsigned*)(ws + WS_MOE + MO_SELE); unsigned* selR = (unsigned*)(ws + WS_MOE + MO_SELR); f32x2* selW = (f32x2*)(ws + WS_MOE + MO_SELW);
    const u32x2* tokpos = (const u32x2*)(ws + WS_MOE + MO_TOKPOS); int* counts = (int*)(ws + WS_MOE + MO_COUNTS);
    const bf16* ymoe = (const bf16*)(ws + WS_R1);
    for (int rb = blockIdx.x; rb < NUC; rb += gridDim.x) {
        for (int rr = 0; rr < 16; ++rr) {
            const int m = rb * 128 + wave * 16 + rr;
            f32x4* xr = (f32x4*)(out + (size_t)m * D) + lane;
            f32x4 v[4]; float s = 0.f;
#pragma unroll
            for (int j = 0; j < 4; ++j) v[j] = xr[64 * j];
            if (MODE == 2) {
                const u32x2 tp = tokpos[m];
                const u32x2* y0 = (const u32x2*)(ymoe + (size_t)tp.x * D) + lane; const u32x2* y1 = (const u32x2*)(ymoe + (size_t)tp.y * D) + lane;
#pragma unroll
                for (int j = 0; j < 4; ++j) { const u32x2 p0 = y0[64 * j], p1 = y1[64 * j];
                    v[j][0] = ALPHA * v[j][0] + __uint_as_float(p0.x << 16) + __uint_as_float(p1.x << 16);
                    v[j][1] = ALPHA * v[j][1] + __uint_as_float(p0.x & 0xffff0000u) + __uint_as_float(p1.x & 0xffff0000u);
                    v[j][2] = ALPHA * v[j][2] + __uint_as_float(p0.y << 16) + __uint_as_float(p1.y << 16);
                    v[j][3] = ALPHA * v[j][3] + __uint_as_float(p0.y & 0xffff0000u) + __uint_as_float(p1.y & 0xffff0000u); }
            }
#pragma unroll
            for (int j = 0; j < 4; ++j) s += (v[j][0] + v[j][1]) + (v[j][2] + v[j][3]);
            const float mean = wave_sum(s) * (1.f / D); float s2 = 0.f;
#pragma unroll
            for (int j = 0; j < 4; ++j) { v[j] = v[j] - mean; s2 += (v[j][0] * v[j][0] + v[j][1] * v[j][1]) + (v[j][2] * v[j][2] + v[j][3] * v[j][3]); }
            const float rstd = __builtin_amdgcn_rsqf(wave_sum(s2) * (1.f / D) + LN_EPS);
            u32x2* o8 = (u32x2*)(xb + (size_t)m * D) + lane;
#pragma unroll
            for (int j = 0; j < 4; ++j) { v[j] = v[j] * rstd * wv[j] + bv[j]; xr[64 * j] = v[j]; u32x2 w; w.x = cvtpk(v[j][0], v[j][1]); w.y = cvtpk(v[j][2], v[j][3]); o8[64 * j] = w; }
            if (MODE == 1) {
                float lg[8];
#pragma unroll
                for (int e = 0; e < 8; ++e) { float p = 0.f;
#pragma unroll
                    for (int j = 0; j < 4; ++j) { const f32x4 w4 = *(const LAS f32x4*)(wrs + e * 1024 + 4 * lane + 256 * j); p += (v[j][0] * w4[0] + v[j][1] * w4[1]) + (v[j][2] * w4[2] + v[j][3] * w4[3]); }
                    lg[e] = wave_sum(p); }
                float best = lg[0]; int e0 = 0;
#pragma unroll
                for (int e = 1; e < 8; ++e) if (lg[e] > best) { best = lg[e]; e0 = e; }
                float sec = -3.0e38f; int e1 = 0;
#pragma unroll
                for (int e = 0; e < 8; ++e) if (e != e0 && lg[e] > sec) { sec = lg[e]; e1 = e; }
                if (lane == 0) {
                    const float w0 = __builtin_amdgcn_rcpf(1.0f + __expf(sec - best));
                    const int lr0 = atomicAdd((int*)&cnt[e0], 1), lr1 = atomicAdd((int*)&cnt[e1], 1);
                    selE[m] = (unsigned)e0 | ((unsigned)e1 << 8); selR[m] = (unsigned)lr0 | ((unsigned)lr1 << 16); selW[m] = (f32x2){w0, 1.0f - w0};
                }
            }
        }
        if (MODE == 1) {
            __syncthreads();
            if (tid < 8) { counts[rb * 8 + tid] = cnt[tid]; cnt[tid] = 0; }
            __syncthreads();
        }
    }
}

__device__ __forceinline__ void moe_gather_phase(ArgsP a, LAS unsigned char* lds, int tid, int lane, int wave) {
    unsigned char* ws = a->ws;
    const unsigned* selE = (const unsigned*)(ws + WS_MOE + MO_SELE); const unsigned* selR = (const unsigned*)(ws + WS_MOE + MO_SELR); const f32x2* selW = (const f32x2*)(ws + WS_MOE + MO_SELW);
    u32x2* tokpos = (u32x2*)(ws + WS_MOE + MO_TOKPOS); float* roww = (float*)(ws + WS_MOE + MO_ROWW); const int* counts = (const int*)(ws + WS_MOE + MO_COUNTS); int* panel_exp = (int*)(ws + WS_MOE + MO_PANEL);
    const bf16* xb = (const bf16*)(ws + WS_R2); bf16* Ag = (bf16*)(ws + WS_R1);
    LAS int* sTot = (LAS int*)lds; LAS int* sPre = sTot + 8; LAS int* sBase = sTot + 16; LAS int* sEb = sTot + 24; LAS int* sPad = sTot + 32;
    for (int rb = blockIdx.x; rb < NUC; rb += gridDim.x) {
        { int tot = 0, pre = 0;
          for (int k = lane; k < NUC; k += 64) { const int cv = counts[k * 8 + wave]; tot += cv; if (k < rb) pre += cv; }
          tot = wave_sum_i(tot); pre = wave_sum_i(pre);
          if (lane == 0) { sTot[wave] = tot; sPre[wave] = pre; } }
        __syncthreads();
        if (tid == 0) { int eb = 0;
            for (int e = 0; e < 8; ++e) { const int pad = ((sTot[e] + 255) >> 8) << 8; sEb[e] = eb; sBase[e] = eb + sPre[e]; sPad[e] = pad; eb += pad; }
            if (rb == 0) { int p = 0; for (int e = 0; e < 8; ++e) for (int k = 0; k < (sPad[e] >> 8); ++k) panel_exp[p++] = e;
                __hip_atomic_store((unsigned*)ws + CW_NP, (unsigned)p, RLX_AGENT); } }
        __syncthreads();
        for (int rr = 0; rr < 16; ++rr) {
            const int m = rb * 128 + wave * 16 + rr;
            const unsigned se = selE[m], sr = selR[m]; const f32x2 w = selW[m];
            const int e0 = se & 255, e1 = (se >> 8) & 255; const unsigned pos0 = sBase[e0] + (sr & 0xffffu), pos1 = sBase[e1] + (sr >> 16);
            const u32x4* src = (const u32x4*)(xb + (size_t)m * D); const u32x4 c0 = src[lane], c1 = src[lane + 64];
            u32x4* d0 = (u32x4*)(Ag + (size_t)pos0 * D); u32x4* d1 = (u32x4*)(Ag + (size_t)pos1 * D);
            d0[lane] = c0; d0[lane + 64] = c1; d1[lane] = c0; d1[lane + 64] = c1;
            if (lane == 0) { roww[pos0] = w.x; roww[pos1] = w.y; tokpos[m] = (u32x2){pos0, pos1}; }
        }
        if (rb < 8) { const int e = rb, n0 = sEb[e] + sTot[e], n1 = sEb[e] + sPad[e];
            for (int r = n0 + wave; r < n1; r += NWAVES) { u32x4* d = (u32x4*)(Ag + (size_t)r * D); d[lane] = (u32x4){0u, 0u, 0u, 0u}; d[lane + 64] = (u32x4){0u, 0u, 0u, 0u}; if (lane == 0) roww[r] = 0.f; } }
        __syncthreads();
    }
}

template <bool APPLY>
__device__ __forceinline__ void s5_unit(ArgsP a, int l, int uc, LAS unsigned char* lds, int tid, int lane, int wave) {
    unsigned char* ws = a->ws;
    const bf16* proj = (const bf16*)(ws + WS_R1);
    const int R0 = uc * CH;
    LAS unsigned char* UT = lds;
    LAS unsigned char* XS = lds + 65536 + wave * 4352;
#pragma unroll
    for (int i = 0; i < 8; ++i) { const int idx = tid + 512 * i, r = idx >> 5, ch = idx & 31;
        *(LAS u32x4*)(UT + r * 512 + ch * 16) = *(const u32x4*)(proj + (size_t)(R0 + r) * NPROJ + PC_U + ch * 8); }
    __syncthreads();
    const int p = lane;
    for (int gg = 0; gg < 2; ++gg) {
        const int g = 2 * wave + gg, lg = l * 16 + g;
        const f32x4 tb4 = *(const f32x4*)((const float*)(ws + WS_MOE + MO_S5TAB) + (size_t)(lg * 64 + p) * 8);
        const float ar = tb4[0], ai = tb4[1], cr = tb4[2], ci = tb4[3];
        float bbr[16], bbi[16];
        { const f32x4* br4 = (const f32x4*)(a->in[I_BRE] + (size_t)(lg * 64 + p) * 16); const f32x4* bi4 = (const f32x4*)(a->in[I_BIM] + (size_t)(lg * 64 + p) * 16);
#pragma unroll
          for (int q = 0; q < 4; ++q) { const f32x4 r4 = br4[q], i4 = bi4[q];
#pragma unroll
              for (int j = 0; j < 4; ++j) { bbr[4 * q + j] = cr * r4[j] - ci * i4[j]; bbi[4 * q + j] = cr * i4[j] + ci * r4[j]; } } }
        float xr = 0.f, xi = 0.f;
        if (APPLY) { const f32x2 c0 = ((const f32x2*)(ws + WS_S5CAR))[(size_t)(uc * 16 + g) * 64 + p]; xr = c0.x; xi = c0.y; }
        bf16x8 cb[4];
        float dsk = 0.f;
        if (APPLY) { const int h = lane & 15;
#pragma unroll
            for (int s = 0; s < 4; ++s) { const int pp = 4 * (lane >> 4) + 16 * s;
                const f32x4 re = *(const f32x4*)(a->in[I_CRE] + (size_t)(lg * 16 + h) * 64 + pp), im = *(const f32x4*)(a->in[I_CIM] + (size_t)(lg * 16 + h) * 64 + pp);
                float tmp[8] = {re[0], -im[0], re[1], -im[1], re[2], -im[2], re[3], -im[3]}; cb[s] = pack8(tmp); }
            dsk = a->in[I_SSMD][l * 256 + g * 16 + h]; }
        for (int tb = 0; tb < 8; ++tb) {
#pragma unroll 4
            for (int tt = 0; tt < 16; ++tt) {
                const int t = tb * 16 + tt;
                const u32x4 u0 = *(const LAS u32x4*)(UT + t * 512 + g * 32), u1 = *(const LAS u32x4*)(UT + t * 512 + g * 32 + 16);
                float uf[16]; unpack8(u0, uf); unpack8(u1, uf + 8);
                float bur = 0.f, bui = 0.f;
#pragma unroll
                for (int h = 0; h < 16; ++h) { bur += bbr[h] * uf[h]; bui += bbi[h] * uf[h]; }
                const float nxr = ar * xr - ai * xi + bur, nxi = ar * xi + ai * xr + bui; xr = nxr; xi = nxi;
                if (APPLY) *(LAS unsigned*)(XS + tt * 272 + p * 4) = cvtpk(xr, xi);
            }
            if (APPLY) {
                LDS_WAIT();
                f32x4 y = {0.f, 0.f, 0.f, 0.f};
#pragma unroll
                for (int s = 0; s < 4; ++s) { const bf16x8 xa = *(const LAS bf16x8*)(XS + (lane & 15) * 272 + ((lane >> 4) * 8 + 32 * s) * 2); y = MFMA16(xa, cb[s], y); }
                const int h = lane & 15;
#pragma unroll
                for (int r = 0; r < 4; ++r) { const int t = tb * 16 + 4 * (lane >> 4) + r; LAS unsigned short* up = (LAS unsigned short*)(UT + t * 512 + (g * 16 + h) * 2);
                    const float yy = y[r] + dsk * bf2f(*up); *up = (unsigned short)(cvtpk(gelu_tanh(yy), 0.f) & 0xffffu); }
                LDS_WAIT();
            }
        }
        if (!APPLY) ((f32x2*)(ws + WS_S5LOC))[(size_t)(uc * 16 + g) * 64 + p] = (f32x2){xr, xi};
    }
    if (APPLY) {
        __syncthreads();
        bf16* gbuf = (bf16*)(ws + WS_GBUF);
#pragma unroll
        for (int i = 0; i < 8; ++i) { const int idx = tid + 512 * i, r = idx >> 5, ch = idx & 31;
            *(u32x4*)(gbuf + (size_t)(R0 + r) * 256 + ch * 8) = *(const LAS u32x4*)(UT + r * 512 + ch * 16); }
    }
    __syncthreads();
}

__device__ __forceinline__ void load_rope(const bf16* rowp, const float* cosr, const float* sinr, int hh, float scale, bf16x8 (&o)[4]) {
    u32x4 raw[4];
#pragma unroll
    for (int s = 0; s < 4; ++s) raw[s] = *(const u32x4*)(rowp + 16 * s + 8 * hh);
#pragma unroll
    for (int s = 0; s < 2; ++s) {
        float x1[8], x2[8], c[8], sn[8], y1[8], y2[8]; unpack8(raw[s], x1); unpack8(raw[s + 2], x2);
        const f32x4 c0 = *(const f32x4*)(cosr + 16 * s + 8 * hh), c1 = *(const f32x4*)(cosr + 16 * s + 8 * hh + 4), s0 = *(const f32x4*)(sinr + 16 * s + 8 * hh), s1 = *(const f32x4*)(sinr + 16 * s + 8 * hh + 4);
#pragma unroll
        for (int j = 0; j < 4; ++j) { c[j] = c0[j]; c[4 + j] = c1[j]; sn[j] = s0[j]; sn[4 + j] = s1[j]; }
#pragma unroll
        for (int j = 0; j < 8; ++j) { y1[j] = (x1[j] * c[j] - x2[j] * sn[j]) * scale; y2[j] = (x1[j] * sn[j] + x2[j] * c[j]) * scale; }
        o[s] = pack8(y1); o[s + 2] = pack8(y2);
    }
}

__device__ __forceinline__ void ret_local_unit(ArgsP a, int uc, int lane, int h) {
    unsigned char* ws = a->ws;
    const bf16* proj = (const bf16*)(ws + WS_R1); const bf16* vT = (const bf16*)(ws + WS_VT);
    const float* cost = (const float*)(ws + WS_ROPE); const float* sint = cost + SEQ * 32;
    const int R0 = uc * CH, s0 = (uc & 127) * CH, cl = lane & 31, hh = lane >> 5;
    const float lg2 = ((const float*)(ws + WS_MOE + MO_RETLG))[h];
    f32x16 kv[2][2];
#pragma unroll
    for (int i = 0; i < 2; ++i)
#pragma unroll
        for (int j = 0; j < 2; ++j)
#pragma unroll
            for (int k = 0; k < 16; ++k) kv[i][j][k] = 0.f;
    bf16x8 idm[2];
#pragma unroll
    for (int s2 = 0; s2 < 2; ++s2) { float t8[8];
#pragma unroll
        for (int j = 0; j < 8; ++j) t8[j] = (16 * s2 + 8 * hh + j == cl) ? 1.0f : 0.0f;
        idm[s2] = pack8(t8); }
    for (int ti = 0; ti < 4; ++ti) {
        const int tl = 32 * ti + tau(cl);
        bf16x8 ka[4]; load_rope(proj + (size_t)(R0 + tl) * NPROJ + PC_RK + h * 64, cost + (size_t)(s0 + tl) * 32, sint + (size_t)(s0 + tl) * 32, hh, 0.125f, ka);
        bf16x8 xb[2][2];
#pragma unroll
        for (int dt = 0; dt < 2; ++dt) { f32x16 x;
#pragma unroll
            for (int k = 0; k < 16; ++k) x[k] = 0.f;
            x = MFMA32(ka[2 * dt], idm[0], x); x = MFMA32(ka[2 * dt + 1], idm[1], x);
            float xs[16];
#pragma unroll
            for (int i = 0; i < 16; ++i) xs[i] = x[i] * __builtin_amdgcn_exp2f((float)(127 - (32 * ti + 16 * hh + i)) * lg2);
            xb[dt][0] = pack8(xs); xb[dt][1] = pack8(xs + 8); }
#pragma unroll
        for (int et = 0; et < 2; ++et)
#pragma unroll
            for (int s = 0; s < 2; ++s) { const bf16x8 va = ld8(vT + (size_t)(VT_RV + h * 64 + 32 * et + cl) * T + R0 + 32 * ti + 16 * hh + 8 * s);
                kv[et][0] = MFMA32(va, xb[0][s], kv[et][0]); kv[et][1] = MFMA32(va, xb[1][s], kv[et][1]); }
    }
    float* retloc = (float*)(ws + WS_RETLOC) + (size_t)(uc * 8 + h) * 4096;
#pragma unroll
    for (int et = 0; et < 2; ++et)
#pragma unroll
        for (int dt = 0; dt < 2; ++dt)
#pragma unroll
            for (int i = 0; i < 16; ++i) { const int e = 32 * et + 8 * (i >> 2) + 4 * hh + (i & 3); retloc[e * 64 + 32 * dt + cl] = kv[et][dt][i]; }
}

__device__ __forceinline__ void ret_apply_unit(ArgsP a, int l, int uc, int lane, int h) {
    unsigned char* ws = a->ws;
    const bf16* proj = (const bf16*)(ws + WS_R1); const bf16* vT = (const bf16*)(ws + WS_VT); bf16* ymix = (bf16*)(ws + WS_R3);
    const bf16* prevT = (const bf16*)(ws + WS_RETPREV) + (size_t)(uc * 8 + h) * 4096;
    const float* cost = (const float*)(ws + WS_ROPE); const float* sint = cost + SEQ * 32;
    const float* gw = a->in[I_RETGW] + l * 512 + h * 64; const float* gb = a->in[I_RETGB] + l * 512 + h * 64;
    const int R0 = uc * CH, s0 = (uc & 127) * CH, cl = lane & 31, hh = lane >> 5;
    const float lg2 = ((const float*)(ws + WS_MOE + MO_RETLG))[h];
    for (int qi = 0; qi < 4; ++qi) {
        const int ql = 32 * qi + cl;
        bf16x8 qb[4]; load_rope(proj + (size_t)(R0 + ql) * NPROJ + PC_RQ + h * 64, cost + (size_t)(s0 + ql) * 32, sint + (size_t)(s0 + ql) * 32, hh, 1.0f, qb);
        f32x16 o[2];
        { const float gq1 = __builtin_amdgcn_exp2f((float)(ql + 1) * lg2);
#pragma unroll
          for (int et = 0; et < 2; ++et) { f32x16 ct;
#pragma unroll
              for (int k = 0; k < 16; ++k) ct[k] = 0.f;
#pragma unroll
              for (int s = 0; s < 4; ++s) { const bf16x8 pa = ld8(prevT + (32 * et + cl) * 64 + 16 * s + 8 * hh); ct = MFMA32(pa, qb[s], ct); }
#pragma unroll
              for (int k = 0; k < 16; ++k) o[et][k] = ct[k] * gq1; } }
        for (int ki = 0; ki <= qi; ++ki) {
            const int kl = 32 * ki + tau(cl);
            bf16x8 ka[4]; load_rope(proj + (size_t)(R0 + kl) * NPROJ + PC_RK + h * 64, cost + (size_t)(s0 + kl) * 32, sint + (size_t)(s0 + kl) * 32, hh, 0.125f, ka);
            f32x16 st;
#pragma unroll
            for (int k = 0; k < 16; ++k) st[k] = 0.f;
#pragma unroll
            for (int s = 0; s < 4; ++s) st = MFMA32(ka[s], qb[s], st);
            float pv[16];
#pragma unroll
            for (int i = 0; i < 16; ++i) { const int dl = ql - (32 * ki + 16 * hh + i); pv[i] = dl >= 0 ? st[i] * __builtin_amdgcn_exp2f((float)dl * lg2) : 0.f; }
            const bf16x8 pb0 = pack8(pv), pb1 = pack8(pv + 8);
#pragma unroll
            for (int et = 0; et < 2; ++et) { const bf16* vp = vT + (size_t)(VT_RV + h * 64 + 32 * et + cl) * T + R0 + 32 * ki + 16 * hh;
                o[et] = MFMA32(ld8(vp), pb0, o[et]); o[et] = MFMA32(ld8(vp + 8), pb1, o[et]); }
        }
        float sm = 0.f;
#pragma unroll
        for (int et = 0; et < 2; ++et)
#pragma unroll
            for (int i = 0; i < 16; ++i) sm += o[et][i];
        sm += __shfl_xor(sm, 32);
        const float mean = sm * (1.0f / 64.0f); float sq = 0.f;
#pragma unroll
        for (int et = 0; et < 2; ++et)
#pragma unroll
            for (int i = 0; i < 16; ++i) { const float d = o[et][i] - mean; sq += d * d; }
        sq += __shfl_xor(sq, 32);
        const float rstd = __builtin_amdgcn_rsqf(sq * (1.0f / 64.0f) + LN_EPS);
        const bf16* gp = proj + (size_t)(R0 + ql) * NPROJ + PC_RG + h * 64; bf16* yp = ymix + (size_t)(R0 + ql) * D + 256 + h * 64;
#pragma unroll
        for (int et = 0; et < 2; ++et)
#pragma unroll
            for (int q4 = 0; q4 < 4; ++q4) { const int e0 = 32 * et + 8 * q4 + 4 * hh;
                const f32x4 w4 = *(const f32x4*)(gw + e0), b4 = *(const f32x4*)(gb + e0); const u32x2 gr = *(const u32x2*)(gp + e0);
                const float g0 = __uint_as_float(gr.x << 16), g1 = __uint_as_float(gr.x & 0xffff0000u), g2 = __uint_as_float(gr.y << 16), g3 = __uint_as_float(gr.y & 0xffff0000u);
                const float v0 = ((o[et][4 * q4 + 0] - mean) * rstd * w4[0] + b4[0]) * pg8::fast_silu(g0), v1 = ((o[et][4 * q4 + 1] - mean) * rstd * w4[1] + b4[1]) * pg8::fast_silu(g1);
                const float v2 = ((o[et][4 * q4 + 2] - mean) * rstd * w4[2] + b4[2]) * pg8::fast_silu(g2), v3 = ((o[et][4 * q4 + 3] - mean) * rstd * w4[3] + b4[3]) * pg8::fast_silu(g3);
                u32x2 w; w.x = cvtpk(v0, v1); w.y = cvtpk(v2, v3); *(u32x2*)(yp + e0) = w; }
    }
}

__device__ __forceinline__ void sb_unit(ArgsP a, int l, int uc, int qi, int hd, int lane) {
    unsigned char* ws = a->ws;
    const bf16* proj = (const bf16*)(ws + WS_R1); const bf16* vT = (const bf16*)(ws + WS_VT); bf16* ymix = (bf16*)(ws + WS_R3);
    const int R0 = uc * CH, b = uc >> 7, s0 = (uc & 127) * CH, cl = lane & 31, hh = lane >> 5;
    const int qrow = R0 + 32 * qi + cl, qpos = s0 + 32 * qi + cl;
    bf16x8 qb[4];
#pragma unroll
    for (int s = 0; s < 4; ++s) qb[s] = ld8(proj + (size_t)qrow * NPROJ + PC_SQ + hd * 64 + 16 * s + 8 * hh);
    f32x16 o[2];
#pragma unroll
    for (int et = 0; et < 2; ++et)
#pragma unroll
        for (int k = 0; k < 16; ++k) o[et][k] = 0.f;
    float R = 0.f;
    for (int kt = (s0 >> 5) + qi; kt >= 0; --kt) {
        const int kbase = b * SEQ + 32 * kt;
        const bf16* kp = proj + (size_t)(kbase + tau(cl)) * NPROJ + PC_SK + hd * 64 + 8 * hh;
        f32x16 st;
#pragma unroll
        for (int k = 0; k < 16; ++k) st[k] = 0.f;
#pragma unroll
        for (int s = 0; s < 4; ++s) st = MFMA32(ld8(kp + 16 * s), qb[s], st);
        float lb[16], aft[16]; float run = 0.f;
#pragma unroll
        for (int i = 15; i >= 0; --i) { const float z = st[i] * 0.125f; const bool valid = (32 * kt + 16 * hh + i) < qpos;
            const float sp = fmaxf(z, 0.f) + __logf(1.0f + __expf(-fabsf(z)));
            lb[i] = valid ? (z - sp) : -1.0e30f;
            aft[i] = run; run += valid ? -sp : 0.f; }
        const float oth = __shfl_xor(run, 32);
        const float off = R + (hh == 0 ? oth : 0.f);
        float pv[16];
#pragma unroll
        for (int i = 0; i < 16; ++i) pv[i] = __expf(lb[i] + aft[i] + off);
        R += run + oth;
        const bf16x8 pb0 = pack8(pv), pb1 = pack8(pv + 8);
#pragma unroll
        for (int et = 0; et < 2; ++et) { const bf16* vp = vT + (size_t)(VT_SV + hd * 64 + 32 * et + cl) * T + kbase + 16 * hh;
            o[et] = MFMA32(ld8(vp), pb0, o[et]); o[et] = MFMA32(ld8(vp + 8), pb1, o[et]); }
        if (__all(R < -SB_THR)) break;
    }
    float ss = 0.f;
#pragma unroll
    for (int et = 0; et < 2; ++et)
#pragma unroll
        for (int i = 0; i < 16; ++i) ss += o[et][i] * o[et][i];
    ss += __shfl_xor(ss, 32);
    const float r = __builtin_amdgcn_rsqf(ss * (1.0f / 64.0f) + LN_EPS);
    const float* nw = a->in[I_SBNW] + l * 256 + hd * 64; bf16* yp = ymix + (size_t)qrow * D + 768 + hd * 64;
#pragma unroll
    for (int et = 0; et < 2; ++et)
#pragma unroll
        for (int q4 = 0; q4 < 4; ++q4) { const int e0 = 32 * et + 8 * q4 + 4 * hh; const f32x4 w4 = *(const f32x4*)(nw + e0);
            u32x2 w; w.x = cvtpk(o[et][4 * q4 + 0] * r * w4[0], o[et][4 * q4 + 1] * r * w4[1]); w.y = cvtpk(o[et][4 * q4 + 2] * r * w4[2], o[et][4 * q4 + 3] * r * w4[3]); *(u32x2*)(yp + e0) = w; }
}

__device__ __forceinline__ void carry_phase(ArgsP a, int l, int tid) {
    unsigned char* ws = a->ws;
    const int gt = blockIdx.x * (NWAVES * 64) + tid, GT = gridDim.x * NWAVES * 64;
    for (int idx = gt; idx < BATCH * 8 * 4096; idx += GT) {
        const int b = idx >> 15, h = (idx >> 12) & 7, ed = idx & 4095;
        const float dec = __builtin_amdgcn_exp2f(128.0f * ((const float*)(ws + WS_MOE + MO_RETLG))[h]);
        const float* loc = (const float*)(ws + WS_RETLOC) + (size_t)(b * 128 * 8 + h) * 4096 + ed; bf16* prv = (bf16*)(ws + WS_RETPREV) + (size_t)(b * 128 * 8 + h) * 4096 + ed;
        float S = 0.f;
#pragma unroll 8
        for (int c = 0; c < 128; ++c) { const float v = loc[(size_t)c * 8 * 4096]; prv[(size_t)c * 8 * 4096] = (unsigned short)(cvtpk(S, 0.f) & 0xffffu); S = dec * S + v; }
    }
    for (int idx = GT - 1 - gt; idx < BATCH * 16 * 64; idx += GT) {
        const int b = idx >> 10, g = (idx >> 6) & 15, p = idx & 63, lg = l * 16 + g;
        const f32x4 tb4 = *(const f32x4*)((const float*)(ws + WS_MOE + MO_S5TAB) + (size_t)(lg * 64 + p) * 8 + 4);
        const float ar = tb4[0], ai = tb4[1];
        const f32x2* loc = (const f32x2*)(ws + WS_S5LOC) + (size_t)(b * 128 * 16 + g) * 64 + p; f32x2* car = (f32x2*)(ws + WS_S5CAR) + (size_t)(b * 128 * 16 + g) * 64 + p;
        float xr = 0.f, xi = 0.f;
#pragma unroll 8
        for (int c = 0; c < 128; ++c) { const f32x2 v = loc[(size_t)c * 16 * 64]; car[(size_t)c * 16 * 64] = (f32x2){xr, xi}; const float nr = ar * xr - ai * xi + v.x, ni = ar * xi + ai * xr + v.y; xr = nr; xi = ni; }
    }
}

#define RELAUNDER() do { int t_ = threadIdx.x; asm volatile("" : "+v"(t_)); tid = t_; lane = tid & 63; wave = __builtin_amdgcn_readfirstlane(tid >> 6); int g_ = gridDim.x, b_ = blockIdx.x; asm volatile("" : "+s"(g_), "+s"(b_)); G = g_; bid = b_; \
        ArgsP p_ = (ArgsP)__builtin_amdgcn_kernarg_segment_ptr(); asm volatile("" : "+s"(p_)); ap = p_; ws = ap->ws; } while (0)
#define GRID_BAR() do { xcd_barrier(bar); RELAUNDER(); } while (0)
#define LAUNDER_LANE() do { int t_ = threadIdx.x; asm volatile("" : "+v"(t_)); tid = t_; lane = tid & 63; wave = __builtin_amdgcn_readfirstlane(tid >> 6); } while (0)
#define xb ((bf16*)(ws + WS_R2))
#define proj ((bf16*)(ws + WS_R1))
#define vT ((bf16*)(ws + WS_VT))
#define ymix ((bf16*)(ws + WS_R3))
#define out (ap->out)


template <int l>
__device__ __forceinline__ void layer_body(const XcdBarrier& bar, LAS unsigned char* lds) {
    int tid, lane, wave, G, bid; ArgsP ap; unsigned char* ws;
    RELAUNDER();
        const bf16* win_t = (const bf16*)(ws + WS_WIN) + (size_t)l * 3072 * 1024;
#ifndef NO_G0
        { pg8::Gemm g{xb, win_t, T, NPROJ, D}; pg8::StaticOrder S; S.init(T, NPROJ, G, bid); pg8::EpiStoreBf16 E{proj, NPROJ};
          pg8::gemm_phase<pg8::EpiStoreBf16, pg8::StaticOrder, PG8_ALIGN, PG8_SP2>(lds + RING_OFF, g, S, E); }
#endif
#ifndef NO_G1
        { pg8::Gemm g{win_t + (size_t)NPROJ * D, xb, NVT, T, D}; pg8::StaticOrder S; S.init(NVT, T, G, bid); pg8::EpiStoreBf16 E{vT, T};
          pg8::gemm_phase<pg8::EpiStoreBf16, pg8::StaticOrder, PG8_ALIGN, PG8_SP2>(lds + RING_OFF, g, S, E); }
#endif
        GRID_BAR();
        for (int uc = bid; uc < NUC; uc += G) {
#ifndef NO_S5L
            LAUNDER_LANE();
            s5_unit<false>(ap, l, uc, lds, tid, lane, wave);
#endif
#ifndef NO_RETL
            LAUNDER_LANE();
            ret_local_unit(ap, uc, lane, wave);
#endif
#ifndef NO_SB
            LAUNDER_LANE();
            sb_unit(ap, l, uc, wave >> 2, wave & 3, lane);
            LAUNDER_LANE();
            sb_unit(ap, l, uc, 2 + (wave >> 2), wave & 3, lane);
#endif
        }
        GRID_BAR();
#ifndef NO_CARRY
        carry_phase(ap, l, tid);
#endif
        GRID_BAR();
        for (int uc = bid; uc < NUC; uc += G) {
#ifndef NO_S5A
            LAUNDER_LANE();
            s5_unit<true>(ap, l, uc, lds, tid, lane, wave);
#endif
#ifndef NO_RETA
            LAUNDER_LANE();
            ret_apply_unit(ap, l, uc, lane, wave);
#endif
        }
        GRID_BAR();
#ifndef NO_G2
        { int kglu = 256; asm volatile("" : "+s"(kglu));
          pg8::Gemm g{(const bf16*)(ws + WS_GBUF), (const bf16*)(ws + WS_GLU) + (size_t)l * 65536, T, 256, kglu}; pg8::StaticOrder S; S.init(T, 256, G, bid);
          pg8::EpiGLU E{(const bf16*)(ws + WS_GBUF), ap->in[I_GLUB] + l * 256, ap->in[I_SSMNW] + l * 256, ymix, D, LN_EPS};
          pg8::gemm_phase<pg8::EpiGLU, pg8::StaticOrder, PG8_ALIGN, PG8_SP2>(lds + RING_OFF, g, S, E); }
#endif
        GRID_BAR();
#ifndef NO_G3
        { pg8::Gemm g{ymix, (const bf16*)(ws + WS_WOUT) + (size_t)l * D * D, T, D, D}; pg8::StaticOrder S; S.init(T, D, G, bid);
          pg8::EpiResF32 E{l == 0 ? ap->in[I_X] : out, out, D, ALPHA};
          pg8::gemm_phase<pg8::EpiResF32, pg8::StaticOrder, PG8_ALIGN, PG8_SP2>(lds + RING_OFF, g, S, E); }
#endif
        GRID_BAR();
        const int li = l >> 1;
        if (l & 1) {
#ifndef NO_LN
            ln_phase<1>(ap, ap->in[I_LNMW] + l * D, ap->in[I_LNMB] + l * D, ap->in[I_ROUTER] + (size_t)li * D * NE, lds, tid, lane, wave);
#endif
            GRID_BAR();
#ifndef NO_LN
            moe_gather_phase(ap, lds, tid, lane, wave);
#endif
            GRID_BAR();
            const int np = (int)__builtin_amdgcn_readfirstlane(__hip_atomic_load((unsigned*)ws + CW_NP, RLX_AGENT));
            const int* panel_exp = (const int*)(ws + WS_MOE + MO_PANEL);
#ifndef NO_G4
            { pg8::Gemm g{(const bf16*)(ws + WS_R1), (const bf16*)(ws + WS_MGU) + (size_t)li * NE * 1536 * 1024, np * 256, 1536, D}; pg8::MoeOrder S{panel_exp, 6, np * 6, G, bid};
              pg8::EpiSwiGLU<true> E{(bf16*)(ws + WS_R2), EFFP, (const float*)(ws + WS_MOE + MO_ROWW)};
              pg8::gemm_phase<pg8::EpiSwiGLU<true>, pg8::MoeOrder, PG8_ALIGN, PG8_SP2>(lds + RING_OFF, g, S, E); }
#endif
            GRID_BAR();
#ifndef NO_G5
            { pg8::Gemm g{(const bf16*)(ws + WS_R2), (const bf16*)(ws + WS_MDN) + (size_t)li * NE * 1024 * EFFP, np * 256, D, EFFP}; pg8::MoeOrder S{panel_exp, 4, np * 4, G, bid};
              pg8::EpiStoreBf16 E{(bf16*)(ws + WS_R1), D};
              pg8::gemm_phase<pg8::EpiStoreBf16, pg8::MoeOrder, PG8_ALIGN, PG8_SP2>(lds + RING_OFF, g, S, E); }
#endif
            GRID_BAR();
#ifndef NO_LN
            ln_phase<2>(ap, ap->in[I_LNFW] + l * D, ap->in[I_LNFB] + l * D, nullptr, lds, tid, lane, wave);
#endif
            GRID_BAR();
        } else {
#ifndef NO_LN
            ln_phase<0>(ap, ap->in[I_LNMW] + l * D, ap->in[I_LNMB] + l * D, nullptr, lds, tid, lane, wave);
#endif
            GRID_BAR();
#ifndef NO_G6
            { pg8::Gemm g{xb, (const bf16*)(ws + WS_FGU) + (size_t)li * 5632 * 1024, T, 5632, D}; pg8::StaticOrder S; S.init(T, 5632, G, bid);
              pg8::EpiSwiGLU<false> E{(bf16*)(ws + WS_R1), DFFP, nullptr};
              pg8::gemm_phase<pg8::EpiSwiGLU<false>, pg8::StaticOrder, PG8_ALIGN, PG8_SP2>(lds + RING_OFF, g, S, E); }
#endif
            GRID_BAR();
#ifndef NO_G7
            { pg8::Gemm g{(const bf16*)(ws + WS_R1), (const bf16*)(ws + WS_FDN) + (size_t)li * 1024 * DFFP, T, D, DFFP}; pg8::StaticOrder S; S.init(T, D, G, bid);
              pg8::EpiResF32 E{out, out, D, ALPHA};
              pg8::gemm_phase<pg8::EpiResF32, pg8::StaticOrder, PG8_ALIGN, PG8_SP2>(lds + RING_OFF, g, S, E); }
#endif
            GRID_BAR();
#ifndef NO_LN
            ln_phase<0>(ap, ap->in[I_LNFW] + l * D, ap->in[I_LNFB] + l * D, nullptr, lds, tid, lane, wave);
#endif
            GRID_BAR();
        }
}

__global__ void __launch_bounds__(NWAVES * 64, 2) hybrid_fwd(Args args) {
    extern __shared__ __attribute__((aligned(16))) unsigned char lds_raw[];
    LAS unsigned char* lds = (LAS unsigned char*)lds_raw;
    int tid, lane, wave, G, bid; ArgsP ap; unsigned char* ws;
    RELAUNDER();
    for (int u = tid; u < (LDS_BYTES - LDSCTL_OFF) / 4; u += NWAVES * 64) ((LAS unsigned*)(lds + LDSCTL_OFF))[u] = 0u;
    __syncthreads();
    XcdBarrier bar = xcd_barrier_post((unsigned*)(ws + WS_CTL) + CW_BAR, (volatile LAS unsigned*)(lds + MISC_OFF) + 8);
#ifndef NO_P0
    p0_prologue(ap, lds, tid, lane, wave);
#endif
    GRID_BAR();
    layer_body<0>(bar, lds); layer_body<1>(bar, lds); layer_body<2>(bar, lds); layer_body<3>(bar, lds);
#undef GRID_BAR
#undef RELAUNDER
#undef LAUNDER_LANE
#undef xb
#undef proj
#undef vT
#undef ymix
#undef out
}

extern "C" void kernel_launch(void* const* d_in, const int* in_sizes, int n_in, void* d_out, int out_size, void* d_ws, size_t ws_size, hipStream_t stream) {
    static int grid = 0;
    if (grid == 0) {
        if (n_in != 28 || out_size != T * D || ws_size < WS_END) { fprintf(stderr, "kernel_launch: unexpected problem shape (n_in %d, out %d, ws %zu); nothing launched\n", n_in, out_size, ws_size); grid = -1; return; }
        int dev = 0, cus = 0, per_cu = 0;
        if (hipGetDevice(&dev) != hipSuccess || hipDeviceGetAttribute(&cus, hipDeviceAttributeMultiprocessorCount, dev) != hipSuccess) { grid = -1; return; }
        if (hipFuncSetAttribute((const void*)hybrid_fwd, hipFuncAttributeMaxDynamicSharedMemorySize, LDS_BYTES) != hipSuccess) { fprintf(stderr, "kernel_launch: hipFuncSetAttribute failed\n"); grid = -1; return; }
        if (hipOccupancyMaxActiveBlocksPerMultiprocessor(&per_cu, (const void*)hybrid_fwd, NWAVES * 64, LDS_BYTES) != hipSuccess || per_cu < 1)
            fprintf(stderr, "kernel_launch: note: occupancy query reports %d workgroups per CU\n", per_cu);
        (void)hipGetLastError();
        grid = cus < 256 ? cus : 256;
    }
    if (grid < 0) return;
    if (hipMemsetAsync((char*)d_ws + WS_CTL, 0, CTL_ZERO_BYTES, stream) != hipSuccess) return;
    Args a{};
    for (int i = 0; i < 28; ++i) a.in[i] = (const float*)d_in[i];
    a.out = (float*)d_out; a.ws = (unsigned char*)d_ws;
    hipLaunchKernelGGL(hybrid_fwd, dim3(grid), dim3(NWAVES * 64), LDS_BYTES, stream, a);
}
```

```cpp
#include <hip/hip_runtime.h>
#include <cstdio>
#include <cstdint>
namespace pg8 {
#define PG8_LAS __attribute__((address_space(3)))
typedef unsigned short bf16_t;
typedef short bf16x8 __attribute__((ext_vector_type(8)));
typedef float f32x4 __attribute__((ext_vector_type(4)));
typedef unsigned u32x4 __attribute__((ext_vector_type(4)));
constexpr int BM = 256, BK = 64, HALF = 128, HTB = HALF * BK * 2  , STAGE_BYTES = 8 * HTB, NXCD = 8, WGM = 8;

__host__ __device__ __forceinline__ int lds_byte(int r, int c) { const int st = (r >> 4) * 2 + (c >> 5), rr = r & 15, cc = c & 31, ob = rr * 64 + cc * 2; return st * 1024 + (ob ^ (((ob >> 9) & 1) << 5)); }
__host__ __device__ __forceinline__ void stage_rc(int b, int& R, int& C) { const int st = b / 1024, sb = b % 1024, swz = sb ^ (((sb >> 9) & 1) << 5); R = (st >> 1) * 16 + swz / 64; C = (st & 1) * 32 + (swz % 64) / 2; }
__host__ __device__ __forceinline__ int perm32(int rho) { const int n = rho >> 4, i = rho & 15; return 8 * (i >> 2) + 4 * n + (i & 3); }

struct Unit { int pm, pn, pb; };
struct Gemm { const bf16_t* A; const bf16_t* Bt; int M, N, K; };

struct StaticOrder {
    int nM, nN, nwg, G, c;
    __host__ __device__ void init(int M, int N, int G_, int c_) { nM = M / BM; nN = N / BM; nwg = nM * nN; G = G_; c = c_; }
    __host__ __device__ bool next(int i, Unit& u) const {
        const long L = (long)i * G + c; if (L >= nwg) return false;
        int wgid = (int)L; { const int q = nwg / NXCD, r = nwg % NXCD, xcd = wgid % NXCD, off = wgid / NXCD; wgid = (xcd < r ? xcd * (q + 1) : r * (q + 1) + (xcd - r) * q) + off; }
        const int nig = WGM * nN, gid = wgid / nig, fm = gid * WGM, gsz = (nM - fm) < WGM ? (nM - fm) : WGM;
        u.pm = fm + ((wgid % nig) % gsz); u.pn = (wgid % nig) / gsz; u.pb = u.pn; return true;
    }
    __device__ __forceinline__ void a_ready(const Unit&) const {}
    __device__ __forceinline__ void done(const Unit&) const {}
};

__device__ __forceinline__ unsigned cvt_pk_bf16(float lo, float hi) { unsigned r; asm volatile("v_cvt_pk_bf16_f32 %0, %1, %2" : "=v"(r) : "v"(lo), "v"(hi)); return r; }
typedef float f32x2 __attribute__((ext_vector_type(2)));
__device__ __forceinline__ f32x2 gelu_pk(f32x2 v) {
    const f32x2 av = __builtin_elementwise_abs(v), d = av * 0.2316418882f + 1.0f;
    f32x2 t; t.x = __builtin_amdgcn_rcpf(d.x); t.y = __builtin_amdgcn_rcpf(d.y);
    f32x2 q = t * 0.5307027145f + (-0.7265760135f); q = q * t + 0.7107068705f; q = q * t + (-0.142248368f); q = q * t + 0.127414796f; q = q * t;
    const f32x2 s = (v * v) * (-0.72134752044f);
    f32x2 e; e.x = __builtin_amdgcn_exp2f(s.x); e.y = __builtin_amdgcn_exp2f(s.y);
    const f32x2 m = v * (q * e), r = v - m;
    f32x2 o; o.x = v.x < 0.f ? m.x : r.x; o.y = v.y < 0.f ? m.y : r.y; return o;
}

__device__ __forceinline__ float fast_silu(float x) { return x * __builtin_amdgcn_rcpf(1.0f + __expf(-x)); }
__device__ __forceinline__ float bf2f(unsigned short b) { return __uint_as_float(((unsigned)b) << 16); }

struct EpiStoreBf16 {
    static constexpr bool PERM = true, AFTER_DRAIN = false;
    bf16_t* O; int ldc;
    __device__ __forceinline__ void operator()(const f32x4 (&acc)[2][2][4][2], const Unit& u, int wr, int wc, int fr, int fq) const {
        const int row0 = u.pm * BM + wr * 64 + fr, col0 = u.pn * BM + wc * 32 + 8 * fq;
#pragma unroll
        for (int ai = 0; ai < 2; ++ai)
#pragma unroll
            for (int m = 0; m < 4; ++m) { bf16_t* rowp = O + (size_t)(row0 + ai * HALF + m * 16) * ldc + col0;
#pragma unroll
                for (int bj = 0; bj < 2; ++bj) { const f32x4 v0 = acc[ai][bj][m][0], v1 = acc[ai][bj][m][1];
                    u32x4 w; w.x = cvt_pk_bf16(v0[0], v0[1]); w.y = cvt_pk_bf16(v0[2], v0[3]); w.z = cvt_pk_bf16(v1[0], v1[1]); w.w = cvt_pk_bf16(v1[2], v1[3]);
                    *(u32x4*)(rowp + bj * HALF) = w; } }
    }
};
struct EpiResF32 {
    static constexpr bool PERM = false, AFTER_DRAIN = false;
    const float* src; float* dst; int ldc; float alpha;
    __device__ __forceinline__ void operator()(const f32x4 (&acc)[2][2][4][2], const Unit& u, int wr, int wc, int fr, int fq) const {
        const int row0 = u.pm * BM + wr * 64 + fr, col0 = u.pn * BM + wc * 32 + 4 * fq;
#pragma unroll
        for (int ai = 0; ai < 2; ++ai)
#pragma unroll
            for (int m = 0; m < 4; ++m) { const size_t ro = (size_t)(row0 + ai * HALF + m * 16) * ldc + col0;
#pragma unroll
                for (int bj = 0; bj < 2; ++bj)
#pragma unroll
                    for (int n = 0; n < 2; ++n) { const f32x4 s = *(const f32x4*)(src + ro + bj * HALF + n * 16); *(f32x4*)(dst + ro + bj * HALF + n * 16) = s * alpha + acc[ai][bj][m][n]; } }
    }
};
template <bool ROWW> struct EpiSwiGLU {
    static constexpr bool PERM = true, AFTER_DRAIN = false;
    bf16_t* H; int ldh; const float* roww;
    __device__ __forceinline__ void operator()(const f32x4 (&acc)[2][2][4][2], const Unit& u, int wr, int wc, int fr, int fq) const {
        const int row0 = u.pm * BM + wr * 64 + fr, col0 = u.pn * HALF + wc * 32 + 8 * fq;
#pragma unroll
        for (int ai = 0; ai < 2; ++ai)
#pragma unroll
            for (int m = 0; m < 4; ++m) { const int row = row0 + ai * HALF + m * 16; const float rw = ROWW ? roww[row] : 1.0f;
                float h[8];
#pragma unroll
                for (int n = 0; n < 2; ++n)
#pragma unroll
                    for (int j = 0; j < 4; ++j) h[4 * n + j] = fast_silu(acc[ai][0][m][n][j]) * acc[ai][1][m][n][j] * rw;
                u32x4 w; w.x = cvt_pk_bf16(h[0], h[1]); w.y = cvt_pk_bf16(h[2], h[3]); w.z = cvt_pk_bf16(h[4], h[5]); w.w = cvt_pk_bf16(h[6], h[7]);
                *(u32x4*)(H + (size_t)row * ldh + col0) = w; }
    }
};
struct EpiGLU {
    static constexpr bool PERM = true, AFTER_DRAIN = false;
    const bf16_t* G; const float* glu_b; const float* norm_w; bf16_t* Y; int ldy; float eps;
    __device__ __forceinline__ void operator()(const f32x4 (&acc)[2][2][4][2], const Unit& u, int wr, int wc, int fr, int fq) const {
        const int row0 = u.pm * BM + wr * 64 + fr, col0 = wc * 32 + 8 * fq;
        const bf16_t* G = this->G; const float* glu_b = this->glu_b; const float* norm_w = this->norm_w; bf16_t* Y = this->Y;
        asm volatile("" : "+s"(G), "+s"(glu_b), "+s"(norm_w), "+s"(Y));
#pragma unroll
        for (int bj = 0; bj < 2; ++bj) { const int col = col0 + bj * HALF;
            const f32x4 b0 = *(const f32x4*)(glu_b + col), b1 = *(const f32x4*)(glu_b + col + 4), n0 = *(const f32x4*)(norm_w + col), n1 = *(const f32x4*)(norm_w + col + 4);
#pragma unroll
            for (int ai = 0; ai < 2; ++ai)
#pragma unroll
                for (int m = 0; m < 4; ++m) { const int row = row0 + ai * HALF + m * 16;
                    const u32x4 gr = *(const u32x4*)(G + (size_t)row * 256 + col);
                    float gv[8]; gv[0] = __uint_as_float(gr.x << 16); gv[1] = __uint_as_float(gr.x & 0xffff0000u); gv[2] = __uint_as_float(gr.y << 16); gv[3] = __uint_as_float(gr.y & 0xffff0000u);
                    gv[4] = __uint_as_float(gr.z << 16); gv[5] = __uint_as_float(gr.z & 0xffff0000u); gv[6] = __uint_as_float(gr.w << 16); gv[7] = __uint_as_float(gr.w & 0xffff0000u);
                    float o[8]; float ss = 0.f;
#pragma unroll
                    for (int j = 0; j < 4; ++j) { const float z0 = acc[ai][bj][m][0][j] + b0[j], z1 = acc[ai][bj][m][1][j] + b1[j];
                        o[j] = gv[j] * __builtin_amdgcn_rcpf(1.0f + __expf(-z0)); o[4 + j] = gv[4 + j] * __builtin_amdgcn_rcpf(1.0f + __expf(-z1)); ss += o[j] * o[j] + o[4 + j] * o[4 + j]; }
                    ss += __shfl_xor(ss, 16);
                    const float r = __builtin_amdgcn_rsqf(ss * (1.0f / 16.0f) + eps);
                    u32x4 w; w.x = cvt_pk_bf16(o[0] * r * n0[0], o[1] * r * n0[1]); w.y = cvt_pk_bf16(o[2] * r * n0[2], o[3] * r * n0[3]);
                    w.z = cvt_pk_bf16(o[4] * r * n1[0], o[5] * r * n1[1]); w.w = cvt_pk_bf16(o[6] * r * n1[2], o[7] * r * n1[3]);
                    *(u32x4*)(Y + (size_t)row * ldy + col) = w; asm volatile("" ::: "memory"); } }
    }
};
struct MoeOrder {
    const int* panel_exp; int NT, nunits, G, c;
    __device__ __forceinline__ bool next(int i, Unit& u) const {
        const int L = i * G + c; if (L >= nunits) return false;
        const int p = L / NT, t = L - p * NT; u.pm = p; u.pn = t; u.pb = __builtin_amdgcn_readfirstlane(panel_exp[p]) * NT + t; return true;
    }
    __device__ __forceinline__ void a_ready(const Unit&) const {}
    __device__ __forceinline__ void done(const Unit&) const {}
};

template <class Epi, class Sched, bool ALIGN_EPI = false, bool SP2 = false>
__device__ __forceinline__ void gemm_phase(PG8_LAS unsigned char* lds, const Gemm g, const Sched& S, const Epi& E) {
    int tid_o = threadIdx.x; asm volatile("" : "+v"(tid_o));
    const int tid = tid_o, wid = __builtin_amdgcn_readfirstlane(tid >> 6), lane = tid & 63, wr = wid >> 2, wc = wid & 3, fr = lane & 15, fq = lane >> 4;
    const int K = g.K, nt = K / BK;
    unsigned voffA[2], voffB[2];
#pragma unroll
    for (int i = 0; i < 2; ++i) { int R, C; stage_rc(tid * 16 + i * 8192, R, C); const int Rb = Epi::PERM ? ((R & ~31) + perm32(R & 31)) : R;
        voffA[i] = (unsigned)(R * K + C) * 2u; voffB[i] = (unsigned)(Rb * K + C) * 2u; }
    const size_t kstep = (size_t)(BK * 2);
    const size_t hstep = (size_t)HALF * K * 2;
    const size_t tstep = 2 * hstep;
    const unsigned ldsw = (unsigned)wid * 1024u;
    const int aoff = lds_byte(wr * 64 + fr, fq * 8), boff = lds_byte(wc * 32 + fr, fq * 8);
#define PG8_SA(b, h) (((b) * 2 + (h)) * HTB)
#define PG8_SB(b, h) ((4 + (b) * 2 + (h)) * HTB)
#define PG8_STAGE(bufoff, gbase, voff) do { _Pragma("unroll") for (int _i = 0; _i < 2; ++_i) \
        __builtin_amdgcn_global_load_lds((const unsigned*)((const char*)(gbase) + (voff)[_i]), (PG8_LAS unsigned*)(lds + (bufoff) + ldsw + _i * 8192), 16, 0, 0); } while (0)
#define PG8_LDA(dst, b, h) do { _Pragma("unroll") for (int m = 0; m < 4; ++m) _Pragma("unroll") for (int k = 0; k < 2; ++k) dst[m][k] = *(const PG8_LAS bf16x8*)(lds + PG8_SA(b, h) + aoff + m * 2048 + k * 1024); } while (0)
#define PG8_LDB(dst, b, h) do { _Pragma("unroll") for (int n = 0; n < 2; ++n) _Pragma("unroll") for (int k = 0; k < 2; ++k) dst[n][k] = *(const PG8_LAS bf16x8*)(lds + PG8_SB(b, h) + boff + n * 2048 + k * 1024); } while (0)
#define PG8_MMA(ai, bj, At, Bt) do { __builtin_amdgcn_s_setprio(1); _Pragma("unroll") for (int m = 0; m < 4; ++m) _Pragma("unroll") for (int n = 0; n < 2; ++n) _Pragma("unroll") for (int k = 0; k < 2; ++k) \
        acc[ai][bj][m][n] = __builtin_amdgcn_mfma_f32_16x16x32_bf16(Bt[n][k], At[m][k], acc[ai][bj][m][n], 0, 0, 0); __builtin_amdgcn_s_setprio(0); } while (0)
#define PG8_WAIT_V(n) asm volatile("s_waitcnt vmcnt(" #n ")" ::: "memory")
#define PG8_WAIT_L(n) asm volatile("s_waitcnt lgkmcnt(" #n ")" ::: "memory")
#define PG8_BAR __builtin_amdgcn_s_barrier()
#define PG8_SCHED __builtin_amdgcn_sched_barrier(0)
    Unit cur, nxt; int ui = 0;
    if (!S.next(0, cur)) return;
    f32x4 acc[2][2][4][2];
#pragma unroll
    for (int a = 0; a < 2; ++a)
#pragma unroll
        for (int b = 0; b < 2; ++b)
#pragma unroll
            for (int m = 0; m < 4; ++m)
#pragma unroll
                for (int n = 0; n < 2; ++n) acc[a][b][m][n] = (f32x4){0.f, 0.f, 0.f, 0.f};
    bf16x8 At[4][2], B0[2][2], B1[2][2];
    const char* cA = (const char*)g.A + (size_t)cur.pm * tstep; const char* cB = (const char*)g.Bt + (size_t)cur.pb * tstep;
    S.a_ready(cur);
    if constexpr (SP2) {
        PG8_STAGE(PG8_SB(0, 0), cB, voffB); PG8_STAGE(PG8_SB(0, 1), cB + hstep, voffB); PG8_STAGE(PG8_SA(0, 0), cA, voffA); PG8_STAGE(PG8_SA(0, 1), cA + hstep, voffA);
        if (wr == 1) PG8_BAR;
        PG8_WAIT_V(2); PG8_BAR;
        PG8_STAGE(PG8_SB(1, 0), cB + kstep, voffB); PG8_STAGE(PG8_SA(1, 0), cA + kstep, voffA); PG8_STAGE(PG8_SB(1, 1), cB + hstep + kstep, voffB);
        PG8_WAIT_V(6); PG8_BAR;
    } else {
        PG8_STAGE(PG8_SB(0, 0), cB, voffB); PG8_STAGE(PG8_SA(0, 0), cA, voffA); PG8_STAGE(PG8_SB(0, 1), cB + hstep, voffB); PG8_STAGE(PG8_SA(0, 1), cA + hstep, voffA);
        if (wr == 1) PG8_BAR;
        PG8_WAIT_V(4); PG8_BAR;
        PG8_STAGE(PG8_SB(1, 0), cB + kstep, voffB); PG8_STAGE(PG8_SA(1, 0), cA + kstep, voffA); PG8_STAGE(PG8_SB(1, 1), cB + hstep + kstep, voffB);
        PG8_WAIT_V(6); PG8_BAR;
    }
    for (;;) {
        const bool has_next = S.next(ui + 1, nxt);
        const char* nA = has_next ? (const char*)g.A + (size_t)nxt.pm * tstep : cA; const char* nB = has_next ? (const char*)g.Bt + (size_t)nxt.pb * tstep : cB;
        for (int t = 0; t < nt; t += 2) {
            const bool last = (t == nt - 2);
            const char* a1 = cA + (size_t)(t + 1) * kstep;
            const char* a2 = last ? nA : cA + (size_t)(t + 2) * kstep; const char* b2 = last ? nB : cB + (size_t)(t + 2) * kstep;
            const char* a3 = a2 + kstep; const char* b3 = b2 + kstep;
            if (last && has_next) S.a_ready(nxt);
            if constexpr (SP2) {
            PG8_LDB(B0, 0, 0); PG8_LDB(B1, 0, 1); PG8_SCHED; PG8_LDA(At, 0, 0); PG8_STAGE(PG8_SA(1, 1), a1 + hstep, voffA);
            PG8_WAIT_V(8); PG8_WAIT_L(0); PG8_BAR; PG8_MMA(0, 0, At, B0); PG8_MMA(0, 1, At, B1); PG8_BAR; PG8_SCHED;
            PG8_LDA(At, 0, 1); PG8_STAGE(PG8_SB(0, 0), b2, voffB); PG8_STAGE(PG8_SB(0, 1), b2 + hstep, voffB); PG8_STAGE(PG8_SA(0, 0), a2, voffA);
            PG8_WAIT_V(8); PG8_WAIT_L(0); PG8_BAR; PG8_MMA(1, 0, At, B0); PG8_MMA(1, 1, At, B1); PG8_BAR; PG8_SCHED;
            PG8_LDB(B0, 1, 0); PG8_LDB(B1, 1, 1); PG8_SCHED; PG8_LDA(At, 1, 0); PG8_STAGE(PG8_SA(0, 1), a2 + hstep, voffA);
            PG8_WAIT_V(8); PG8_WAIT_L(0); PG8_BAR; PG8_MMA(0, 0, At, B0); PG8_MMA(0, 1, At, B1); PG8_BAR; PG8_SCHED;
            PG8_LDA(At, 1, 1); PG8_STAGE(PG8_SB(1, 0), b3, voffB); PG8_STAGE(PG8_SB(1, 1), b3 + hstep, voffB); PG8_STAGE(PG8_SA(1, 0), a3, voffA);
            PG8_WAIT_V(8); PG8_WAIT_L(0); PG8_BAR; PG8_MMA(1, 0, At, B0); PG8_MMA(1, 1, At, B1); PG8_BAR; PG8_SCHED;
            } else {
            PG8_LDB(B0, 0, 0); PG8_SCHED; PG8_LDA(At, 0, 0); PG8_STAGE(PG8_SA(1, 1), a1 + hstep, voffA);
            PG8_WAIT_L(8); PG8_BAR; PG8_WAIT_L(0); PG8_MMA(0, 0, At, B0); PG8_BAR; PG8_SCHED;
            PG8_LDB(B1, 0, 1); PG8_STAGE(PG8_SB(0, 0), b2, voffB);
            PG8_BAR; PG8_WAIT_L(0); PG8_MMA(0, 1, At, B1); PG8_BAR;
            PG8_LDA(At, 0, 1); PG8_STAGE(PG8_SA(0, 0), a2, voffA);
            PG8_BAR; PG8_WAIT_L(0); PG8_MMA(1, 0, At, B0); PG8_BAR; PG8_SCHED;
            PG8_STAGE(PG8_SB(0, 1), b2 + hstep, voffB);
            PG8_WAIT_V(6); PG8_BAR; PG8_MMA(1, 1, At, B1); PG8_BAR;
            PG8_LDB(B0, 1, 0); PG8_SCHED; PG8_LDA(At, 1, 0); PG8_STAGE(PG8_SA(0, 1), a2 + hstep, voffA);
            PG8_WAIT_L(8); PG8_BAR; PG8_WAIT_L(0); PG8_MMA(0, 0, At, B0); PG8_BAR; PG8_SCHED;
            PG8_LDB(B1, 1, 1); PG8_STAGE(PG8_SB(1, 0), b3, voffB);
            PG8_BAR; PG8_WAIT_L(0); PG8_MMA(0, 1, At, B1); PG8_BAR;
            PG8_LDA(At, 1, 1); PG8_STAGE(PG8_SA(1, 0), a3, voffA);
            PG8_BAR; PG8_WAIT_L(0); PG8_MMA(1, 0, At, B0); PG8_BAR; PG8_SCHED;
            PG8_STAGE(PG8_SB(1, 1), b3 + hstep, voffB);
            PG8_WAIT_V(6); PG8_BAR; PG8_MMA(1, 1, At, B1); PG8_BAR;
            }
        }
        if constexpr (ALIGN_EPI) { if (wr == 0) PG8_BAR; }
        if constexpr (!Epi::AFTER_DRAIN) { E(acc, cur, wr, wc, fr, fq); S.done(cur); }
        if (!has_next) break;
#pragma unroll
        for (int a = 0; a < 2; ++a)
#pragma unroll
            for (int b = 0; b < 2; ++b)
#pragma unroll
                for (int m = 0; m < 4; ++m)
#pragma unroll
                    for (int n = 0; n < 2; ++n) acc[a][b][m][n] = (f32x4){0.f, 0.f, 0.f, 0.f};
        cur = nxt; cA = nA; cB = nB; ++ui;
        if constexpr (ALIGN_EPI) { if (wr == 1) PG8_BAR; }
    }
    PG8_WAIT_V(0);
    if constexpr (!ALIGN_EPI) { if (wr == 0) PG8_BAR; }
    PG8_BAR;
    if constexpr (Epi::AFTER_DRAIN) { E.fused(acc, cur, wr, wc, fr, fq, lds, wid, lane); S.done(cur); }
#undef PG8_SA
#undef PG8_SB
#undef PG8_STAGE
#undef PG8_LDA
#undef PG8_LDB
#undef PG8_MMA
#undef PG8_WAIT_V
#undef PG8_WAIT_L
#undef PG8_BAR
#undef PG8_SCHED
}
}
#define PG8_SP2 true
#define PG8_ALIGN true

constexpr int BATCH = 2, SEQ = 16384, T = BATCH * SEQ, D = 1024, DEPTH = 4;
constexpr int NPROJ = 2304, NVT = 768;
constexpr int PC_U = 0, PC_RQ = 256, PC_RK = 768, PC_RG = 1280, PC_SQ = 1792, PC_SK = 2048, VT_RV = 0, VT_SV = 512;
constexpr int DFF = 2752, DFFP = 2816, EFF = 688, EFFP = 768, NE = 8;
constexpr int CH = 128, NUC = T / CH;
constexpr int MAXPAN = 264, MAXROWS = MAXPAN * 256;
constexpr float ALPHA = 1.6817928305074290f, LN_EPS = 1e-5f;
constexpr float SB_THR = 30.0f;

constexpr size_t MiB = 1u << 20;
constexpr size_t WS_CTL = 0, CTL_ZERO_BYTES = 1 * MiB;
constexpr size_t WS_WIN = 1 * MiB, WS_WOUT = 25 * MiB, WS_FGU = 33 * MiB, WS_FDN = 55 * MiB, WS_MGU = 66 * MiB, WS_MDN = 114 * MiB, WS_GLU = 138 * MiB;
constexpr size_t WS_ROPE = 139 * MiB;
constexpr size_t WS_S5LOC = 143 * MiB, WS_S5CAR = 145 * MiB;
constexpr size_t WS_MOE = 147 * MiB;
constexpr size_t MO_S5TAB = 1792 * 1024, MO_RETLG = 1920 * 1024;
constexpr size_t MO_SELE = 0, MO_SELR = 128 * 1024, MO_SELW = 256 * 1024, MO_TOKPOS = 512 * 1024, MO_ROWW = 768 * 1024, MO_COUNTS = 1280 * 1024, MO_PANEL = 1536 * 1024;
constexpr size_t WS_R1 = 149 * MiB;
constexpr size_t WS_VT = WS_R1 + 144 * MiB;
constexpr size_t WS_R2 = 341 * MiB;
constexpr size_t WS_RETLOC = WS_R2, WS_RETPREV = WS_R2 + 32 * MiB, WS_GBUF = WS_R2 + 48 * MiB;
constexpr size_t WS_R3 = 405 * MiB;
constexpr size_t WS_END = 469 * MiB;
static_assert((size_t)MAXROWS * EFFP * 2 <= 128 * MiB && (size_t)MAXROWS * 1024 * 2 <= 192 * MiB && (size_t)T * DFFP * 2 <= 192 * MiB, "overlay sizes");
constexpr int CW_TMO = 0, CW_NP = 64, CW_BAR = 4096;

constexpr int RING_OFF = 0, RING_BYTES = 131072;
constexpr int LDSCTL_OFF = 146432, MISC_OFF = LDSCTL_OFF + 320;
constexpr int LDS_BYTES = 147456;
constexpr int NWAVES = 8;

#define GAS __attribute__((address_space(1)))
#define LAS __attribute__((address_space(3)))
typedef unsigned short bf16;
typedef unsigned u32x4 __attribute__((ext_vector_type(4)));
typedef unsigned u32x2 __attribute__((ext_vector_type(2)));
typedef float f32x4 __attribute__((ext_vector_type(4)));
typedef float f32x2 __attribute__((ext_vector_type(2)));
typedef float f32x16 __attribute__((ext_vector_type(16)));
typedef short bf16x8 __attribute__((ext_vector_type(8)));
typedef GAS unsigned gu32;
#define RLX_AGENT __ATOMIC_RELAXED, __HIP_MEMORY_SCOPE_AGENT
#define LDS_WAIT() asm volatile("s_waitcnt lgkmcnt(0)" ::: "memory")
#define VM_WAIT() asm volatile("s_waitcnt vmcnt(0)" ::: "memory")

#define XB_TMO      128
#define XB_XCNT(j)  (256  + 64 * (j))
#define XB_XSUB(j)  (1280 + 64 * (j))
#define XB_XGEN(j)  (2304 + 64 * (j))
#define XB_TOP      3328
#define XB_TOPGEN   3392
#define XCD_BAR_WORDS 3456
#define XB_SPIN_CAP (1u << 18)

__device__ __forceinline__ unsigned xb_ld(unsigned* p)              { return __hip_atomic_load(p, __ATOMIC_RELAXED, __HIP_MEMORY_SCOPE_AGENT); }
__device__ __forceinline__ unsigned xb_add(unsigned* p, unsigned v) { return __hip_atomic_fetch_add(p, v, __ATOMIC_RELAXED, __HIP_MEMORY_SCOPE_AGENT); }
__device__ __forceinline__ unsigned xb_xcc_id() { return (unsigned)__builtin_amdgcn_s_getreg((3 << 11) | 20) & 0xFu; }
#define XB_SPIN(cond, bar) do { unsigned _sp = 0; while (cond) { __builtin_amdgcn_s_sleep(1); \
    if ((++_sp & 255u) == 0u) { if (xb_ld(&(bar)[XB_TMO])) break; if (_sp > XB_SPIN_CAP) { atomicAdd(&(bar)[XB_TMO], 1u); break; } } } } while (0)

struct XcdBarrier {
    unsigned* bar; unsigned x;
    volatile LAS unsigned* st;
};

__device__ __forceinline__ XcdBarrier xcd_barrier_post(unsigned* bar, volatile LAS unsigned* st) {
    XcdBarrier b; b.bar = bar; b.x = xb_xcc_id(); b.st = st;
    if (threadIdx.x == 0) (void)xb_add(&bar[XB_XCNT(b.x)], 1u);
    return b;
}
__device__ __forceinline__ void xcd_barrier_complete(unsigned* bar, unsigned x, unsigned& nloc, unsigned& nx) {
    const unsigned G = gridDim.x * gridDim.y * gridDim.z;
    unsigned sum, cnt, mine, sp = 0u;
    for (;;) {
        sum = 0u; cnt = 0u; mine = 0u;
#pragma unroll
        for (unsigned j = 0; j < 16; ++j) { const unsigned c = xb_ld(&bar[XB_XCNT(j)]); sum += c; cnt += (c > 0u) ? 1u : 0u; mine = (j == x) ? c : mine; }
        if (sum == G) break;
        __builtin_amdgcn_s_sleep(1);
        if ((++sp & 255u) == 0u) { if (xb_ld(&bar[XB_TMO])) break; if (sp > XB_SPIN_CAP) { atomicAdd(&bar[XB_TMO], 1u); break; } }
    }
    nloc = mine > 0u ? mine : 1u; nx = cnt > 0u ? cnt : 1u;
}

__device__ __forceinline__ void xcd_barrier(const XcdBarrier& b) {
    asm volatile("s_waitcnt vmcnt(0)" ::: "memory");
    __syncthreads();
    if (threadIdx.x == 0) {
        unsigned* bar = b.bar; asm volatile("" : "+s"(bar));
        __builtin_amdgcn_s_waitcnt(0);
        unsigned nloc = b.st[0], nx = b.st[1];
        if (nloc == 0u) { xcd_barrier_complete(bar, b.x, nloc, nx); b.st[0] = nloc; b.st[1] = nx; }
        const unsigned old = xb_add(&bar[XB_XSUB(b.x)], 1u);
        const unsigned gen = old / nloc;
        if (old + 1u == (gen + 1u) * nloc) {
            __builtin_amdgcn_fence(__ATOMIC_RELEASE, "agent");
            asm volatile("s_waitcnt vmcnt(0)" ::: "memory");
            const unsigned og = xb_add(&bar[XB_TOP], 1u);
            const unsigned tg = og / nx;
            if (og + 1u == (tg + 1u) * nx) xb_add(&bar[XB_TOPGEN], 1u);
            else XB_SPIN(xb_ld(&bar[XB_TOPGEN]) == tg, bar);
            __builtin_amdgcn_fence(__ATOMIC_ACQUIRE, "agent");
            xb_add(&bar[XB_XGEN(b.x)], 1u);
            asm volatile("s_waitcnt vmcnt(0)" ::: "memory");
        } else {
            XB_SPIN(xb_ld(&bar[XB_XGEN(b.x)]) == gen, bar);
            __builtin_amdgcn_fence(__ATOMIC_ACQUIRE, "agent");
            asm volatile("s_waitcnt vmcnt(0)" ::: "memory");
        }
    }
    __syncthreads();
}

__device__ __forceinline__ float bf2f(unsigned short b) { return __uint_as_float(((unsigned)b) << 16); }
__device__ __forceinline__ unsigned cvtpk(float lo, float hi) { return pg8::cvt_pk_bf16(lo, hi); }
__device__ __forceinline__ float wave_sum(float v) {
#pragma unroll
    for (int o = 1; o < 64; o <<= 1) v += __shfl_xor(v, o);
    return v;
}
__device__ __forceinline__ int wave_sum_i(int v) {
#pragma unroll
    for (int o = 1; o < 64; o <<= 1) v += __shfl_xor(v, o);
    return v;
}
__device__ __forceinline__ bf16x8 ld8(const bf16* p) { return __builtin_bit_cast(bf16x8, *(const u32x4*)p); }
__device__ __forceinline__ bf16x8 pack8(const float* a) { u32x4 w; w.x = cvtpk(a[0], a[1]); w.y = cvtpk(a[2], a[3]); w.z = cvtpk(a[4], a[5]); w.w = cvtpk(a[6], a[7]); return __builtin_bit_cast(bf16x8, w); }
__device__ __forceinline__ void unpack8(const u32x4 r, float* o) {
    o[0] = __uint_as_float(r.x << 16); o[1] = __uint_as_float(r.x & 0xffff0000u); o[2] = __uint_as_float(r.y << 16); o[3] = __uint_as_float(r.y & 0xffff0000u);
    o[4] = __uint_as_float(r.z << 16); o[5] = __uint_as_float(r.z & 0xffff0000u); o[6] = __uint_as_float(r.w << 16); o[7] = __uint_as_float(r.w & 0xffff0000u);
}
__device__ __forceinline__ int tau(int r) { return 16 * ((r >> 2) & 1) + 4 * (r >> 3) + (r & 3); }
#define MFMA32(a, b, c) __builtin_amdgcn_mfma_f32_32x32x16_bf16(a, b, c, 0, 0, 0)
#define MFMA16(a, b, c) __builtin_amdgcn_mfma_f32_16x16x32_bf16(a, b, c, 0, 0, 0)
__device__ __forceinline__ float gelu_tanh(float x) {
    const float a = 0.7978845608028654f * (x + 0.044715f * x * x * x);
    const float th = 1.0f - 2.0f * __builtin_amdgcn_rcpf(1.0f + __expf(2.0f * a));
    return 0.5f * x * (1.0f + th);
}

struct Args { const float* in[28]; float* out; unsigned char* ws; };
typedef const __attribute__((address_space(4))) Args* ArgsP;
enum { I_X = 0, I_WIN, I_LAMRE, I_LAMIM, I_LOGDT, I_BRE, I_BIM, I_CRE, I_CIM, I_SSMD, I_GLUW, I_GLUB, I_SSMNW, I_RETGW, I_RETGB, I_SBNW, I_WOUT, I_LNMW, I_LNMB,
       I_FG, I_FU, I_FD, I_ROUTER, I_MG, I_MU, I_MD, I_LNFW, I_LNFB };

__device__ __forceinline__ void tr_item(const float* W, int Ks, int Ns, bf16* WT, int Kd, int k0, int n0, int drow0, LAS float* scr, int lane) {
#pragma unroll 8
    for (int i = 0; i < 32; ++i) { const int kk = 2 * i + (lane >> 5), k = k0 + kk, n = n0 + (lane & 31);
        scr[kk * 33 + (lane & 31)] = (k < Ks && n < Ns) ? W[(size_t)k * Ns + n] : 0.f; }
    LDS_WAIT(); asm volatile("" ::: "memory");
    const int c = lane & 7;
#pragma unroll
    for (int j = 0; j < 4; ++j) { const int n = (lane >> 3) + 8 * j; const LAS float* s = scr + (8 * c) * 33 + n;
        u32x4 o; o.x = cvtpk(s[0 * 33], s[1 * 33]); o.y = cvtpk(s[2 * 33], s[3 * 33]); o.z = cvtpk(s[4 * 33], s[5 * 33]); o.w = cvtpk(s[6 * 33], s[7 * 33]);
        *(u32x4*)(WT + (size_t)(drow0 + n) * Kd + k0 + 8 * c) = o; }
    LDS_WAIT(); asm volatile("" ::: "memory");
}
__device__ __forceinline__ void p0_prologue(ArgsP a, LAS unsigned char* lds, int tid, int lane, int wave) {
    unsigned char* ws = a->ws;
    LAS float* scr = (LAS float*)(lds + wave * 16384);
    const int gw = blockIdx.x * NWAVES + wave, NGW = gridDim.x * NWAVES;
    constexpr int NA = 4 * 1536, NB = 4 * 512, NC = 2 * 2816, ND = 2 * 1408, NEE = 16 * 768, NF = 16 * 384, NG = 4 * 32;
    constexpr int NITEMS = NA + NB + NC + ND + NEE + NF + NG;
    for (int it = gw; it < NITEMS; it += NGW) {
        int r = it;
        if (r < NA) { const int l = r / 1536, q = r % 1536, kb = q / 96, nb = q % 96, c = 32 * nb;
            const int drow = c < 1280 ? c : (c < 1792 ? 2304 + (c - 1280) : (c < 2816 ? c - 512 : c));
            tr_item(a->in[I_WIN] + (size_t)l * 1024 * 3072, 1024, 3072, (bf16*)(ws + WS_WIN) + (size_t)l * 3072 * 1024, 1024, 64 * kb, c, drow, scr, lane); continue; }
        r -= NA;
        if (r < NB) { const int l = r / 512, q = r % 512, kb = q / 32, nb = q % 32;
            tr_item(a->in[I_WOUT] + (size_t)l * 1024 * 1024, 1024, 1024, (bf16*)(ws + WS_WOUT) + (size_t)l * 1024 * 1024, 1024, 64 * kb, 32 * nb, 32 * nb, scr, lane); continue; }
        r -= NB;
        if (r < NC) { const int li = r / 2816, q = r % 2816, db = q / 16, kb = q % 16, pn = db >> 3, wi = db & 7, ffc = 128 * pn + 32 * (wi & 3);
            const float* src = (wi >> 2) ? a->in[I_FU] : a->in[I_FG];
            tr_item(src + (size_t)li * 1024 * DFF, 1024, DFF, (bf16*)(ws + WS_FGU) + (size_t)li * 5632 * 1024, 1024, 64 * kb, ffc, 32 * db, scr, lane); continue; }
        r -= NC;
        if (r < ND) { const int li = r / 1408, q = r % 1408, kb = q / 32, nb = q % 32;
            tr_item(a->in[I_FD] + (size_t)li * DFF * 1024, DFF, 1024, (bf16*)(ws + WS_FDN) + (size_t)li * 1024 * DFFP, DFFP, 64 * kb, 32 * nb, 32 * nb, scr, lane); continue; }
        r -= ND;
        if (r < NEE) { const int le = r / 768, q = r % 768, db = q / 16, kb = q % 16, pn = db >> 3, wi = db & 7, ffc = 128 * pn + 32 * (wi & 3);
            const float* src = (wi >> 2) ? a->in[I_MU] : a->in[I_MG];
            tr_item(src + (size_t)le * 1024 * EFF, 1024, EFF, (bf16*)(ws + WS_MGU) + (size_t)le * 1536 * 1024, 1024, 64 * kb, ffc, 32 * db, scr, lane); continue; }
        r -= NEE;
        if (r < NF) { const int le = r / 384, q = r % 384, kb = q / 32, nb = q % 32;
            tr_item(a->in[I_MD] + (size_t)le * EFF * 1024, EFF, 1024, (bf16*)(ws + WS_MDN) + (size_t)le * 1024 * EFFP, EFFP, 64 * kb, 32 * nb, 32 * nb, scr, lane); continue; }
        r -= NF;
        { const int l = r / 32, q = r % 32, kb = q / 8, nb = q % 8;
            tr_item(a->in[I_GLUW] + (size_t)l * 65536, 256, 256, (bf16*)(ws + WS_GLU) + (size_t)l * 65536, 256, 64 * kb, 32 * nb, 32 * nb, scr, lane); }
    }
    { const f32x4* x4 = (const f32x4*)a->in[I_X]; u32x4* o = (u32x4*)(ws + WS_R2);
      const size_t n8 = (size_t)T * D / 8, gt = (size_t)blockIdx.x * (NWAVES * 64) + tid, GT = (size_t)gridDim.x * NWAVES * 64;
      for (size_t i = gt; i < n8; i += GT) { const f32x4 v0 = x4[2 * i], v1 = x4[2 * i + 1]; u32x4 w; w.x = cvtpk(v0[0], v0[1]); w.y = cvtpk(v0[2], v0[3]); w.z = cvtpk(v1[0], v1[1]); w.w = cvtpk(v1[2], v1[3]); o[i] = w; } }
    { float* tab = (float*)(ws + WS_MOE + MO_S5TAB);
      const int gt = blockIdx.x * (NWAVES * 64) + tid, GT = gridDim.x * NWAVES * 64;
      for (int i = gt; i < DEPTH * 16 * 64; i += GT) { const int lg = i >> 6;
          const float lr = a->in[I_LAMRE][i], li = a->in[I_LAMIM][i], dt = expf(a->in[I_LOGDT][lg]);
          const float zr = lr * dt, zi = li * dt; float sn, cs; sincosf(zi, &sn, &cs);
          const float mag = expf(zr), ar = mag * cs, ai = mag * sn;
          const float sh = sinf(0.5f * zi); const float mr = expm1f(zr) * cs - 2.0f * sh * sh, mi = ai;
          const float den = 1.0f / (lr * lr + li * li);
          const float cr = (mr * lr + mi * li) * den, ci = (mi * lr - mr * li) * den;
          const double zr128 = (double)lr * (double)dt * 128.0, zi128 = (double)li * (double)dt * 128.0; const double m128 = exp(zr128);
          f32x4* o = (f32x4*)(tab + (size_t)i * 8); o[0] = (f32x4){ar, ai, cr, ci}; o[1] = (f32x4){(float)(m128 * cos(zi128)), (float)(m128 * sin(zi128)), 0.f, 0.f}; }
      if (gt < 8) ((float*)(ws + WS_MOE + MO_RETLG))[gt] = (float)log2(1.0 - exp2(-5.0 - (double)gt)); }
    { float* ct = (float*)(ws + WS_ROPE); float* st = ct + SEQ * 32;
      const int gt = blockIdx.x * (NWAVES * 64) + tid, GT = gridDim.x * NWAVES * 64;
      for (int i = gt; i < SEQ * 32; i += GT) { const int pos = i >> 5, f = i & 31; const double inv = exp(-(double)f * (9.210340371976184 / 32.0)); const double ang = (double)pos * inv;
          ct[i] = (float)cos(ang); st[i] = (float)sin(ang); } }
}

template <int MODE>
__device__ __forceinline__ void ln_phase(ArgsP a, const float* lnw, const float* lnb, const float* wrouter, LAS unsigned char* lds, int tid, int lane, int wave) {
    unsigned char* ws = a->ws;
    float* out = a->out; bf16* xb = (bf16*)(ws + WS_R2);
    f32x4 wv[4], bv[4];
#pragma unroll
    for (int j = 0; j < 4; ++j) { wv[j] = ((const f32x4*)lnw)[lane + 64 * j]; bv[j] = ((const f32x4*)lnb)[lane + 64 * j]; }
    LAS float* wrs = (LAS float*)lds; LAS int* cnt = (LAS int*)(lds + 32768);
    if (MODE == 1) {
        for (int i = tid; i < 8192; i += NWAVES * 64) { const int c = i >> 3, e = i & 7; wrs[e * 1024 + c] = wrouter[i]; }
        if (tid < 8) cnt[tid] = 0;
        __syncthreads();
    }
    unsigned* selE = (unsigned*)(ws + WS_MOE + MO_SELE); unsigned* selR = (unsigned*)(ws + WS_MOE + MO_SELR); f32x2* selW = (f32x2*)(ws + WS_MOE + MO_SELW);
    const u32x2* tokpos = (const u32x2*)(ws + WS_MOE + MO_TOKPOS); int* counts = (int*)(ws + WS_MOE + MO_COUNTS);
    const bf16* ymoe = (const bf16*)(ws + WS_R1);
    for (int rb = blockIdx.x; rb < NUC; rb += gridDim.x) {
        for (int rr = 0; rr < 16; ++rr) {
            const int m = rb * 128 + wave * 16 + rr;
            f32x4* xr = (f32x4*)(out + (size_t)m * D) + lane;
            f32x4 v[4]; float s = 0.f;
#pragma unroll
            for (int j = 0; j < 4; ++j) v[j] = xr[64 * j];
            if (MODE == 2) {
                const u32x2 tp = tokpos[m];
                const u32x2* y0 = (const u32x2*)(ymoe + (size_t)tp.x * D) + lane; const u32x2* y1 = (const u32x2*)(ymoe + (size_t)tp.y * D) + lane;
#pragma unroll
                for (int j = 0; j < 4; ++j) { const u32x2 p0 = y0[64 * j], p1 = y1[64 * j];
                    v[j][0] = ALPHA * v[j][0] + __uint_as_float(p0.x << 16) + __uint_as_float(p1.x << 16);
                    v[j][1] = ALPHA * v[j][1] + __uint_as_float(p0.x & 0xffff0000u) + __uint_as_float(p1.x & 0xffff0000u);
                    v[j][2] = ALPHA * v[j][2] + __uint_as_float(p0.y << 16) + __uint_as_float(p1.y << 16);
                    v[j][3] = ALPHA * v[j][3] + __uint_as_float(p0.y & 0xffff0000u) + __uint_as_float(p1.y & 0xffff0000u); }
            }
#pragma unroll
            for (int j = 0; j < 4; ++j) s += (v[j][0] + v[j][1]) + (v[j][2] + v[j][3]);
            const float mean = wave_sum(s) * (1.f / D); float s2 = 0.f;
#pragma unroll
            for (int j = 0; j < 4; ++j) { v[j] = v[j] - mean; s2 += (v[j][0] * v[j][0] + v[j][1] * v[j][1]) + (v[j][2] * v[j][2] + v[j][3] * v[j][3]); }
            const float rstd = __builtin_amdgcn_rsqf(wave_sum(s2) * (1.f / D) + LN_EPS);
            u32x2* o8 = (u32x2*)(xb + (size_t)m * D) + lane;
#pragma unroll
            for (int j = 0; j < 4; ++j) { v[j] = v[j] * rstd * wv[j] + bv[j]; xr[64 * j] = v[j]; u32x2 w; w.x = cvtpk(v[j][0], v[j][1]); w.y = cvtpk(v[j][2], v[j][3]); o8[64 * j] = w; }
            if (MODE == 1) {
                float lg[8];
#pragma unroll
                for (int e = 0; e < 8; ++e) { float p = 0.f;
#pragma unroll
                    for (int j = 0; j < 4; ++j) { const f32x4 w4 = *(const LAS f32x4*)(wrs + e * 1024 + 4 * lane + 256 * j); p += (v[j][0] * w4[0] + v[j][1] * w4[1]) + (v[j][2] * w4[2] + v[j][3] * w4[3]); }
                    lg[e] = wave_sum(p); }
                float best = lg[0]; int e0 = 0;
#pragma unroll
                for (int e = 1; e < 8; ++e) if (lg[e] > best) { best = lg[e]; e0 = e; }
                float sec = -3.0e38f; int e1 = 0;
#pragma unroll
                for (int e = 0; e < 8; ++e) if (e != e0 && lg[e] > sec) { sec = lg[e]; e1 = e; }
                if (lane == 0) {
                    const float w0 = __builtin_amdgcn_rcpf(1.0f + __expf(sec - best));
                    const int lr0 = atomicAdd((int*)&cnt[e0], 1), lr1 = atomicAdd((int*)&cnt[e1], 1);
                    selE[m] = (unsigned)e0 | ((unsigned)e1 << 8); selR[m] = (unsigned)lr0 | ((unsigned)lr1 << 16); selW[m] = (f32x2){w0, 1.0f - w0};
                }
            }
        }
        if (MODE == 1) {
            __syncthreads();
            if (tid < 8) { counts[rb * 8 + tid] = cnt[tid]; cnt[tid] = 0; }
            __syncthreads();
        }
    }
}

__device__ __forceinline__ void moe_gather_phase(ArgsP a, LAS unsigned char* lds, int tid, int lane, int wave) {
    unsigned char* ws = a->ws;
    const unsigned* selE = (const unsigned*)(ws + WS_MOE + MO_SELE); const unsigned* selR = (const unsigned*)(ws + WS_MOE + MO_SELR); const f32x2* selW = (const f32x2*)(ws + WS_MOE + MO_SELW);
    u32x2* tokpos = (u32x2*)(ws + WS_MOE + MO_TOKPOS); float* roww = (float*)(ws + WS_MOE + MO_ROWW); const int* counts = (const int*)(ws + WS_MOE + MO_COUNTS); int* panel_exp = (int*)(ws + WS_MOE + MO_PANEL);
    const bf16* xb = (const bf16*)(ws + WS_R2); bf16* Ag = (bf16*)(ws + WS_R1);
    LAS int* sTot = (LAS int*)lds; LAS int* sPre = sTot + 8; LAS int* sBase = sTot + 16; LAS int* sEb = sTot + 24; LAS int* sPad = sTot + 32;
    for (int rb = blockIdx.x; rb < NUC; rb += gridDim.x) {
        { int tot = 0, pre = 0;
          for (int k = lane; k < NUC; k += 64) { const int cv = counts[k * 8 + wave]; tot += cv; if (k < rb) pre += cv; }
          tot = wave_sum_i(tot); pre = wave_sum_i(pre);
          if (lane == 0) { sTot[wave] = tot; sPre[wave] = pre; } }
        __syncthreads();
        if (tid == 0) { int eb = 0;
            for (int e = 0; e < 8; ++e) { const int pad = ((sTot[e] + 255) >> 8) << 8; sEb[e] = eb; sBase[e] = eb + sPre[e]; sPad[e] = pad; eb += pad; }
            if (rb == 0) { int p = 0; for (int e = 0; e < 8; ++e) for (int k = 0; k < (sPad[e] >> 8); ++k) panel_exp[p++] = e;
                __hip_atomic_store((unsigned*)ws + CW_NP, (unsigned)p, RLX_AGENT); } }
        __syncthreads();
        for (int rr = 0; rr < 16; ++rr) {
            const int m = rb * 128 + wave * 16 + rr;
            const unsigned se = selE[m], sr = selR[m]; const f32x2 w = selW[m];
            const int e0 = se & 255, e1 = (se >> 8) & 255; const unsigned pos0 = sBase[e0] + (sr & 0xffffu), pos1 = sBase[e1] + (sr >> 16);
            const u32x4* src = (const u32x4*)(xb + (size_t)m * D); const u32x4 c0 = src[lane], c1 = src[lane + 64];
            u32x4* d0 = (u32x4*)(Ag + (size_t)pos0 * D); u32x4* d1 = (u32x4*)(Ag + (size_t)pos1 * D);
            d0[lane] = c0; d0[lane + 64] = c1; d1[lane] = c0; d1[lane + 64] = c1;
            if (lane == 0) { roww[pos0] = w.x; roww[pos1] = w.y; tokpos[m] = (u32x2){pos0, pos1}; }
        }
        if (rb < 8) { const int e = rb, n0 = sEb[e] + sTot[e], n1 = sEb[e] + sPad[e];
            for (int r = n0 + wave; r < n1; r += NWAVES) { u32x4* d = (u32x4*)(Ag + (size_t)r * D); d[lane] = (u32x4){0u, 0u, 0u, 0u}; d[lane + 64] = (u32x4){0u, 0u, 0u, 0u}; if (lane == 0) roww[r] = 0.f; } }
        __syncthreads();
    }
}

template <bool APPLY>
__device__ __forceinline__ void s5_unit(ArgsP a, int l, int uc, LAS unsigned char* lds, int tid, int lane, int wave) {
    unsigned char* ws = a->ws;
    const bf16* proj = (const bf16*)(ws + WS_R1);
    const int R0 = uc * CH;
    LAS unsigned char* UT = lds;
    LAS unsigned char* XS = lds + 65536 + wave * 8704;
#pragma unroll
    for (int i = 0; i < 8; ++i) { const int idx = tid + 512 * i, r = idx >> 5, ch = idx & 31;
        *(LAS u32x4*)(UT + r * 512 + ch * 16) = *(const u32x4*)(proj + (size_t)(R0 + r) * NPROJ + PC_U + ch * 8); }
    __syncthreads();
    const int cl = lane & 31, hh = lane >> 5, g0 = 2 * wave, lg0 = l * 16 + g0;
    const float* tab = (const float*)(ws + WS_MOE + MO_S5TAB);
    bf16x8 bb[2][4];
#pragma unroll
    for (int gi = 0; gi < 2; ++gi)
#pragma unroll
        for (int pc = 0; pc < 2; ++pc) { const int gp = (lg0 + gi) * 64 + 32 * pc + cl;
            const f32x4 t4 = *(const f32x4*)(tab + (size_t)gp * 8); const float cr = t4[2], ci = t4[3];
            const f32x4 r0 = *(const f32x4*)(a->in[I_BRE] + (size_t)gp * 16 + 8 * hh), r1 = *(const f32x4*)(a->in[I_BRE] + (size_t)gp * 16 + 8 * hh + 4);
            const f32x4 i0 = *(const f32x4*)(a->in[I_BIM] + (size_t)gp * 16 + 8 * hh), i1 = *(const f32x4*)(a->in[I_BIM] + (size_t)gp * 16 + 8 * hh + 4);
            float re[8], im[8];
#pragma unroll
            for (int j = 0; j < 4; ++j) { re[j] = cr * r0[j] - ci * i0[j]; im[j] = cr * i0[j] + ci * r0[j]; re[4 + j] = cr * r1[j] - ci * i1[j]; im[4 + j] = cr * i1[j] + ci * r1[j]; }
            bb[gi][pc] = pack8(re); bb[gi][2 + pc] = pack8(im); }
    float ar[2], ai[2], xr[2], xi[2];
#pragma unroll
    for (int pc = 0; pc < 2; ++pc) { const int gp = (lg0 + hh) * 64 + 32 * pc + cl; const f32x2 t2 = *(const f32x2*)(tab + (size_t)gp * 8); ar[pc] = t2.x; ai[pc] = t2.y; xr[pc] = 0.f; xi[pc] = 0.f;
        if (APPLY) { const f32x2 c0 = ((const f32x2*)(ws + WS_S5CAR))[(size_t)(uc * 16 + g0 + hh) * 64 + 32 * pc + cl]; xr[pc] = c0.x; xi[pc] = c0.y; } }
    bf16x8 cb[2][4]; float dsk[2] = {0.f, 0.f};
    if (APPLY) { const int h = lane & 15;
#pragma unroll
        for (int gi = 0; gi < 2; ++gi) {
#pragma unroll
            for (int s = 0; s < 4; ++s) { const int pp = 4 * (lane >> 4) + 16 * s;
                const f32x4 re = *(const f32x4*)(a->in[I_CRE] + (size_t)((lg0 + gi) * 16 + h) * 64 + pp), im = *(const f32x4*)(a->in[I_CIM] + (size_t)((lg0 + gi) * 16 + h) * 64 + pp);
                float tmp[8] = {re[0], -im[0], re[1], -im[1], re[2], -im[2], re[3], -im[3]}; cb[gi][s] = pack8(tmp); }
            dsk[gi] = a->in[I_SSMD][l * 256 + (g0 + gi) * 16 + h]; } }
    const int tr = tau(cl), gh = tr >> 4, ti = tr & 15;
    const LAS unsigned char* ua = UT + ti * 512 + ((g0 + gh) * 16 + 8 * hh) * 2;
    for (int tb = 0; tb < 8; ++tb) {
        const u32x4 uraw = *(const LAS u32x4*)(ua + tb * 16 * 512);
        const u32x4 z4 = {0u, 0u, 0u, 0u};
        const bf16x8 a0 = __builtin_bit_cast(bf16x8, gh == 0 ? uraw : z4), a1 = __builtin_bit_cast(bf16x8, gh == 1 ? uraw : z4);
        f32x16 bu[4];
#pragma unroll
        for (int c = 0; c < 4; ++c) {
#pragma unroll
            for (int k = 0; k < 16; ++k) bu[c][k] = 0.f;
            bu[c] = MFMA32(a0, bb[0][c], bu[c]); bu[c] = MFMA32(a1, bb[1][c], bu[c]); }
#pragma unroll
        for (int i = 0; i < 16; ++i) {
#pragma unroll
            for (int pc = 0; pc < 2; ++pc) { const float nr = ar[pc] * xr[pc] - ai[pc] * xi[pc] + bu[pc][i], ni = ar[pc] * xi[pc] + ai[pc] * xr[pc] + bu[2 + pc][i]; xr[pc] = nr; xi[pc] = ni;
                if (APPLY) *(LAS unsigned*)(XS + hh * 4352 + i * 272 + (32 * pc + cl) * 4) = cvtpk(nr, ni); }
        }
        if (APPLY) {
            LDS_WAIT();
            const int h = lane & 15;
#pragma unroll
            for (int gi = 0; gi < 2; ++gi) {
                f32x4 y = {0.f, 0.f, 0.f, 0.f};
#pragma unroll
                for (int s = 0; s < 4; ++s) { const bf16x8 xa = *(const LAS bf16x8*)(XS + gi * 4352 + (lane & 15) * 272 + ((lane >> 4) * 8 + 32 * s) * 2); y = MFMA16(xa, cb[gi][s], y); }
#pragma unroll
                for (int r = 0; r < 4; ++r) { const int t = tb * 16 + 4 * (lane >> 4) + r; LAS unsigned short* up = (LAS unsigned short*)(UT + t * 512 + ((g0 + gi) * 16 + h) * 2);
                    const float yy = y[r] + dsk[gi] * bf2f(*up); *up = (unsigned short)(cvtpk(gelu_tanh(yy), 0.f) & 0xffffu); }
            }
            LDS_WAIT();
        }
    }
    if (!APPLY) {
#pragma unroll
        for (int pc = 0; pc < 2; ++pc) ((f32x2*)(ws + WS_S5LOC))[(size_t)(uc * 16 + g0 + hh) * 64 + 32 * pc + cl] = (f32x2){xr[pc], xi[pc]};
    }
    if (APPLY) {
        __syncthreads();
        bf16* gbuf = (bf16*)(ws + WS_GBUF);
#pragma unroll
        for (int i = 0; i < 8; ++i) { const int idx = tid + 512 * i, r = idx >> 5, ch = idx & 31;
            *(u32x4*)(gbuf + (size_t)(R0 + r) * 256 + ch * 8) = *(const LAS u32x4*)(UT + r * 512 + ch * 16); }
    }
    __syncthreads();
}

__device__ __forceinline__ void load_rope(const bf16* rowp, const float* cosr, const float* sinr, int hh, float scale, bf16x8 (&o)[4]) {
    u32x4 raw[4];
#pragma unroll
    for (int s = 0; s < 4; ++s) raw[s] = *(const u32x4*)(rowp + 16 * s + 8 * hh);
#pragma unroll
    for (int s = 0; s < 2; ++s) {
        float x1[8], x2[8], c[8], sn[8], y1[8], y2[8]; unpack8(raw[s], x1); unpack8(raw[s + 2], x2);
        const f32x4 c0 = *(const f32x4*)(cosr + 16 * s + 8 * hh), c1 = *(const f32x4*)(cosr + 16 * s + 8 * hh + 4), s0 = *(const f32x4*)(sinr + 16 * s + 8 * hh), s1 = *(const f32x4*)(sinr + 16 * s + 8 * hh + 4);
#pragma unroll
        for (int j = 0; j < 4; ++j) { c[j] = c0[j]; c[4 + j] = c1[j]; sn[j] = s0[j]; sn[4 + j] = s1[j]; }
#pragma unroll
        for (int j = 0; j < 8; ++j) { y1[j] = (x1[j] * c[j] - x2[j] * sn[j]) * scale; y2[j] = (x1[j] * sn[j] + x2[j] * c[j]) * scale; }
        o[s] = pack8(y1); o[s + 2] = pack8(y2);
    }
}

__device__ __forceinline__ void ret_local_unit(ArgsP a, int uc, int lane, int h) {
    unsigned char* ws = a->ws;
    const bf16* proj = (const bf16*)(ws + WS_R1); const bf16* vT = (const bf16*)(ws + WS_VT);
    const float* cost = (const float*)(ws + WS_ROPE); const float* sint = cost + SEQ * 32;
    const int R0 = uc * CH, s0 = (uc & 127) * CH, cl = lane & 31, hh = lane >> 5;
    const float lg2 = ((const float*)(ws + WS_MOE + MO_RETLG))[h];
    f32x16 kv[2][2];
#pragma unroll
    for (int i = 0; i < 2; ++i)
#pragma unroll
        for (int j = 0; j < 2; ++j)
#pragma unroll
            for (int k = 0; k < 16; ++k) kv[i][j][k] = 0.f;
    bf16x8 idm[2];
#pragma unroll
    for (int s2 = 0; s2 < 2; ++s2) { float t8[8];
#pragma unroll
        for (int j = 0; j < 8; ++j) t8[j] = (16 * s2 + 8 * hh + j == cl) ? 1.0f : 0.0f;
        idm[s2] = pack8(t8); }
#pragma unroll
    for (int ti = 0; ti < 4; ++ti) {
        const int tl = 32 * ti + tau(cl);
        bf16x8 ka[4]; load_rope(proj + (size_t)(R0 + tl) * NPROJ + PC_RK + h * 64, cost + (size_t)(s0 + tl) * 32, sint + (size_t)(s0 + tl) * 32, hh, 0.125f, ka);
        bf16x8 xb[2][2];
#pragma unroll
        for (int dt = 0; dt < 2; ++dt) { f32x16 x;
#pragma unroll
            for (int k = 0; k < 16; ++k) x[k] = 0.f;
            x = MFMA32(ka[2 * dt], idm[0], x); x = MFMA32(ka[2 * dt + 1], idm[1], x);
            float xs[16];
#pragma unroll
            for (int i = 0; i < 16; ++i) xs[i] = x[i] * __builtin_amdgcn_exp2f((float)(127 - (32 * ti + 16 * hh + i)) * lg2);
            xb[dt][0] = pack8(xs); xb[dt][1] = pack8(xs + 8); }
#pragma unroll
        for (int et = 0; et < 2; ++et)
#pragma unroll
            for (int s = 0; s < 2; ++s) { const bf16x8 va = ld8(vT + (size_t)(VT_RV + h * 64 + 32 * et + cl) * T + R0 + 32 * ti + 16 * hh + 8 * s);
                kv[et][0] = MFMA32(va, xb[0][s], kv[et][0]); kv[et][1] = MFMA32(va, xb[1][s], kv[et][1]); }
    }
    float* retloc = (float*)(ws + WS_RETLOC) + (size_t)(uc * 8 + h) * 4096;
#pragma unroll
    for (int et = 0; et < 2; ++et)
#pragma unroll
        for (int dt = 0; dt < 2; ++dt)
#pragma unroll
            for (int i = 0; i < 16; ++i) { const int e = 32 * et + 8 * (i >> 2) + 4 * hh + (i & 3); retloc[e * 64 + 32 * dt + cl] = kv[et][dt][i]; }
}

__device__ __forceinline__ void ret_apply_unit(ArgsP a, int l, int uc, int lane, int h) {
    unsigned char* ws = a->ws;
    const bf16* proj = (const bf16*)(ws + WS_R1); const bf16* vT = (const bf16*)(ws + WS_VT); bf16* ymix = (bf16*)(ws + WS_R3);
    const bf16* prevT = (const bf16*)(ws + WS_RETPREV) + (size_t)(uc * 8 + h) * 4096;
    const float* cost = (const float*)(ws + WS_ROPE); const float* sint = cost + SEQ * 32;
    const float* gw = a->in[I_RETGW] + l * 512 + h * 64; const float* gb = a->in[I_RETGB] + l * 512 + h * 64;
    const int R0 = uc * CH, s0 = (uc & 127) * CH, cl = lane & 31, hh = lane >> 5;
    const float lg2 = ((const float*)(ws + WS_MOE + MO_RETLG))[h];
    bf16x8 kall[4][4];
#pragma unroll
    for (int qi = 0; qi < 4; ++qi) {
        const int ql = 32 * qi + cl;
        { const int kl = 32 * qi + tau(cl);
          load_rope(proj + (size_t)(R0 + kl) * NPROJ + PC_RK + h * 64, cost + (size_t)(s0 + kl) * 32, sint + (size_t)(s0 + kl) * 32, hh, 0.125f, kall[qi]);
 }
        bf16x8 qb[4]; load_rope(proj + (size_t)(R0 + ql) * NPROJ + PC_RQ + h * 64, cost + (size_t)(s0 + ql) * 32, sint + (size_t)(s0 + ql) * 32, hh, 1.0f, qb);
        f32x16 o[2];
        { const float gq1 = __builtin_amdgcn_exp2f((float)(ql + 1) * lg2);
#pragma unroll
          for (int et = 0; et < 2; ++et) { f32x16 ct;
#pragma unroll
              for (int k = 0; k < 16; ++k) ct[k] = 0.f;
#pragma unroll
              for (int s = 0; s < 4; ++s) { const bf16x8 pa = ld8(prevT + (32 * et + cl) * 64 + 16 * s + 8 * hh); ct = MFMA32(pa, qb[s], ct); }
#pragma unroll
              for (int k = 0; k < 16; ++k) o[et][k] = ct[k] * gq1; } }
#pragma unroll
        for (int ki = 0; ki < 4; ++ki) if (ki <= qi) {
            f32x16 st;
#pragma unroll
            for (int k = 0; k < 16; ++k) st[k] = 0.f;
#pragma unroll
            for (int s = 0; s < 4; ++s) st = MFMA32(kall[ki][s], qb[s], st);
            float pv[16];
#pragma unroll
            for (int i = 0; i < 16; ++i) { const int dl = ql - (32 * ki + 16 * hh + i); pv[i] = dl >= 0 ? st[i] * __builtin_amdgcn_exp2f((float)dl * lg2) : 0.f; }
            const bf16x8 pb0 = pack8(pv), pb1 = pack8(pv + 8);
#pragma unroll
            for (int et = 0; et < 2; ++et) { const bf16* vp = vT + (size_t)(VT_RV + h * 64 + 32 * et + cl) * T + R0 + 32 * ki + 16 * hh; o[et] = MFMA32(ld8(vp), pb0, o[et]); o[et] = MFMA32(ld8(vp + 8), pb1, o[et]); }
        }
        float sm = 0.f;
#pragma unroll
        for (int et = 0; et < 2; ++et)
#pragma unroll
            for (int i = 0; i < 16; ++i) sm += o[et][i];
        sm += __shfl_xor(sm, 32);
        const float mean = sm * (1.0f / 64.0f); float sq = 0.f;
#pragma unroll
        for (int et = 0; et < 2; ++et)
#pragma unroll
            for (int i = 0; i < 16; ++i) { const float d = o[et][i] - mean; sq += d * d; }
        sq += __shfl_xor(sq, 32);
        const float rstd = __builtin_amdgcn_rsqf(sq * (1.0f / 64.0f) + LN_EPS);
        const bf16* gp = proj + (size_t)(R0 + ql) * NPROJ + PC_RG + h * 64; bf16* yp = ymix + (size_t)(R0 + ql) * D + 256 + h * 64;
#pragma unroll
        for (int et = 0; et < 2; ++et)
#pragma unroll
            for (int q4 = 0; q4 < 4; ++q4) { const int e0 = 32 * et + 8 * q4 + 4 * hh;
                const f32x4 w4 = *(const f32x4*)(gw + e0), b4 = *(const f32x4*)(gb + e0); const u32x2 gr = *(const u32x2*)(gp + e0);
                const float g0 = __uint_as_float(gr.x << 16), g1 = __uint_as_float(gr.x & 0xffff0000u), g2 = __uint_as_float(gr.y << 16), g3 = __uint_as_float(gr.y & 0xffff0000u);
                const float v0 = ((o[et][4 * q4 + 0] - mean) * rstd * w4[0] + b4[0]) * pg8::fast_silu(g0), v1 = ((o[et][4 * q4 + 1] - mean) * rstd * w4[1] + b4[1]) * pg8::fast_silu(g1);
                const float v2 = ((o[et][4 * q4 + 2] - mean) * rstd * w4[2] + b4[2]) * pg8::fast_silu(g2), v3 = ((o[et][4 * q4 + 3] - mean) * rstd * w4[3] + b4[3]) * pg8::fast_silu(g3);
                u32x2 w; w.x = cvtpk(v0, v1); w.y = cvtpk(v2, v3); *(u32x2*)(yp + e0) = w; }
    }
}

__device__ __forceinline__ void sb_unit(ArgsP a, int l, int uc, int qi, int hd, int lane) {
    unsigned char* ws = a->ws;
    const bf16* proj = (const bf16*)(ws + WS_R1); const bf16* vT = (const bf16*)(ws + WS_VT); bf16* ymix = (bf16*)(ws + WS_R3);
    const int R0 = uc * CH, b = uc >> 7, s0 = (uc & 127) * CH, cl = lane & 31, hh = lane >> 5;
    const int qrow = R0 + 32 * qi + cl, qpos = s0 + 32 * qi + cl;
    bf16x8 qb[4];
#pragma unroll
    for (int s = 0; s < 4; ++s) qb[s] = ld8(proj + (size_t)qrow * NPROJ + PC_SQ + hd * 64 + 16 * s + 8 * hh);
    f32x16 o[2];
#pragma unroll
    for (int et = 0; et < 2; ++et)
#pragma unroll
        for (int k = 0; k < 16; ++k) o[et][k] = 0.f;
    float R = 0.f;
    int kt = (s0 >> 5) + qi;
    const bf16* kp0 = proj + (size_t)(b * SEQ + tau(cl)) * NPROJ + PC_SK + hd * 64 + 8 * hh;
    const bf16* vp0 = vT + (size_t)(VT_SV + hd * 64 + cl) * T + b * SEQ + 16 * hh;
    bf16x8 kc[4], vc[4];
#pragma unroll
    for (int s = 0; s < 4; ++s) kc[s] = ld8(kp0 + (size_t)(32 * kt) * NPROJ + 16 * s);
#pragma unroll
    for (int et = 0; et < 2; ++et) { vc[2 * et] = ld8(vp0 + (size_t)(32 * et) * T + 32 * kt); vc[2 * et + 1] = ld8(vp0 + (size_t)(32 * et) * T + 32 * kt + 8); }
    for (;;) {
        const int ktn = kt > 0 ? kt - 1 : 0;
        bf16x8 kn[4], vn[4];
#pragma unroll
        for (int s = 0; s < 4; ++s) kn[s] = ld8(kp0 + (size_t)(32 * ktn) * NPROJ + 16 * s);
#pragma unroll
        for (int et = 0; et < 2; ++et) { vn[2 * et] = ld8(vp0 + (size_t)(32 * et) * T + 32 * ktn); vn[2 * et + 1] = ld8(vp0 + (size_t)(32 * et) * T + 32 * ktn + 8); }
        f32x16 st;
#pragma unroll
        for (int k = 0; k < 16; ++k) st[k] = 0.f;
#pragma unroll
        for (int s = 0; s < 4; ++s) st = MFMA32(kc[s], qb[s], st);
        float lb[16], aft[16]; float run = 0.f;
#pragma unroll
        for (int i = 15; i >= 0; --i) { const float z = st[i] * 0.125f; const bool valid = (32 * kt + 16 * hh + i) < qpos;
            const float sp = fmaxf(z, 0.f) + __logf(1.0f + __expf(-fabsf(z)));
            lb[i] = valid ? (z - sp) : -1.0e30f;
            aft[i] = run; run += valid ? -sp : 0.f; }
        const float oth = __shfl_xor(run, 32);
        const float off = R + (hh == 0 ? oth : 0.f);
        float pv[16];
#pragma unroll
        for (int i = 0; i < 16; ++i) pv[i] = __expf(lb[i] + aft[i] + off);
        R += run + oth;
        const bf16x8 pb0 = pack8(pv), pb1 = pack8(pv + 8);
#pragma unroll
        for (int et = 0; et < 2; ++et) { o[et] = MFMA32(vc[2 * et], pb0, o[et]); o[et] = MFMA32(vc[2 * et + 1], pb1, o[et]); }
        if (kt == 0 || __all(R < -SB_THR)) break;
        kt = ktn;
#pragma unroll
        for (int s = 0; s < 4; ++s) { kc[s] = kn[s]; vc[s] = vn[s]; }
    }
    float ss = 0.f;
#pragma unroll
    for (int et = 0; et < 2; ++et)
#pragma unroll
        for (int i = 0; i < 16; ++i) ss += o[et][i] * o[et][i];
    ss += __shfl_xor(ss, 32);
    const float r = __builtin_amdgcn_rsqf(ss * (1.0f / 64.0f) + LN_EPS);
    const float* nw = a->in[I_SBNW] + l * 256 + hd * 64; bf16* yp = ymix + (size_t)qrow * D + 768 + hd * 64;
#pragma unroll
    for (int et = 0; et < 2; ++et)
#pragma unroll
        for (int q4 = 0; q4 < 4; ++q4) { const int e0 = 32 * et + 8 * q4 + 4 * hh; const f32x4 w4 = *(const f32x4*)(nw + e0);
            u32x2 w; w.x = cvtpk(o[et][4 * q4 + 0] * r * w4[0], o[et][4 * q4 + 1] * r * w4[1]); w.y = cvtpk(o[et][4 * q4 + 2] * r * w4[2], o[et][4 * q4 + 3] * r * w4[3]); *(u32x2*)(yp + e0) = w; }
}

__device__ __forceinline__ void carry_phase(ArgsP a, int l, int tid) {
    unsigned char* ws = a->ws;
    const int gt = blockIdx.x * (NWAVES * 64) + tid, GT = gridDim.x * NWAVES * 64;
    for (int idx = gt; idx < BATCH * 8 * 4096; idx += GT) {
        const int b = idx >> 15, h = (idx >> 12) & 7, ed = idx & 4095;
        const float dec = __builtin_amdgcn_exp2f(128.0f * ((const float*)(ws + WS_MOE + MO_RETLG))[h]);
        const float* loc = (const float*)(ws + WS_RETLOC) + (size_t)(b * 128 * 8 + h) * 4096 + ed; bf16* prv = (bf16*)(ws + WS_RETPREV) + (size_t)(b * 128 * 8 + h) * 4096 + ed;
        float S = 0.f;
#pragma unroll 8
        for (int c = 0; c < 128; ++c) { const float v = loc[(size_t)c * 8 * 4096]; prv[(size_t)c * 8 * 4096] = (unsigned short)(cvtpk(S, 0.f) & 0xffffu); S = dec * S + v; }
    }
    for (int idx = GT - 1 - gt; idx < BATCH * 16 * 64; idx += GT) {
        const int b = idx >> 10, g = (idx >> 6) & 15, p = idx & 63, lg = l * 16 + g;
        const f32x4 tb4 = *(const f32x4*)((const float*)(ws + WS_MOE + MO_S5TAB) + (size_t)(lg * 64 + p) * 8 + 4);
        const float ar = tb4[0], ai = tb4[1];
        const f32x2* loc = (const f32x2*)(ws + WS_S5LOC) + (size_t)(b * 128 * 16 + g) * 64 + p; f32x2* car = (f32x2*)(ws + WS_S5CAR) + (size_t)(b * 128 * 16 + g) * 64 + p;
        float xr = 0.f, xi = 0.f;
#pragma unroll 8
        for (int c = 0; c < 128; ++c) { const f32x2 v = loc[(size_t)c * 16 * 64]; car[(size_t)c * 16 * 64] = (f32x2){xr, xi}; const float nr = ar * xr - ai * xi + v.x, ni = ar * xi + ai * xr + v.y; xr = nr; xi = ni; }
    }
}

#define RELAUNDER() do { int t_ = threadIdx.x; asm volatile("" : "+v"(t_)); tid = t_; lane = tid & 63; wave = __builtin_amdgcn_readfirstlane(tid >> 6); int g_ = gridDim.x, b_ = blockIdx.x; asm volatile("" : "+s"(g_), "+s"(b_)); G = g_; bid = b_; \
        ArgsP p_ = (ArgsP)__builtin_amdgcn_kernarg_segment_ptr(); asm volatile("" : "+s"(p_)); ap = p_; ws = ap->ws; } while (0)
#define GRID_BAR() do { xcd_barrier(bar); RELAUNDER(); } while (0)
#define LAUNDER_LANE() do { int t_ = threadIdx.x; asm volatile("" : "+v"(t_)); tid = t_; lane = tid & 63; wave = __builtin_amdgcn_readfirstlane(tid >> 6); } while (0)
#define xb ((bf16*)(ws + WS_R2))
#define proj ((bf16*)(ws + WS_R1))
#define vT ((bf16*)(ws + WS_VT))
#define ymix ((bf16*)(ws + WS_R3))
#define out (ap->out)


template <int l>
__device__ __forceinline__ void layer_body(const XcdBarrier& bar, LAS unsigned char* lds) {
    int tid, lane, wave, G, bid; ArgsP ap; unsigned char* ws;
    RELAUNDER();
        const bf16* win_t = (const bf16*)(ws + WS_WIN) + (size_t)l * 3072 * 1024;
#ifndef NO_G0
        { pg8::Gemm g{xb, win_t, T, NPROJ, D}; pg8::StaticOrder S; S.init(T, NPROJ, G, bid); pg8::EpiStoreBf16 E{proj, NPROJ};
          pg8::gemm_phase<pg8::EpiStoreBf16, pg8::StaticOrder, PG8_ALIGN, PG8_SP2>(lds + RING_OFF, g, S, E); }
#endif
#ifndef NO_G1
        { pg8::Gemm g{win_t + (size_t)NPROJ * D, xb, NVT, T, D}; pg8::StaticOrder S; S.init(NVT, T, G, bid); pg8::EpiStoreBf16 E{vT, T};
          pg8::gemm_phase<pg8::EpiStoreBf16, pg8::StaticOrder, PG8_ALIGN, PG8_SP2>(lds + RING_OFF, g, S, E); }
#endif
        GRID_BAR();
        for (int uc = bid; uc < NUC; uc += G) {
#ifndef NO_S5L
            LAUNDER_LANE();
            s5_unit<false>(ap, l, uc, lds, tid, lane, wave);
#endif
#ifndef NO_RETL
            LAUNDER_LANE();
            ret_local_unit(ap, uc, lane, wave);
#endif
#ifndef NO_SB
            LAUNDER_LANE();
            sb_unit(ap, l, uc, wave >> 2, wave & 3, lane);
            LAUNDER_LANE();
            sb_unit(ap, l, uc, 2 + (wave >> 2), wave & 3, lane);
#endif
        }
        GRID_BAR();
#ifndef NO_CARRY
        carry_phase(ap, l, tid);
#endif
        GRID_BAR();
        for (int uc = bid; uc < NUC; uc += G) {
#ifndef NO_S5A
            LAUNDER_LANE();
            s5_unit<true>(ap, l, uc, lds, tid, lane, wave);
#endif
#ifndef NO_RETA
            LAUNDER_LANE();
            ret_apply_unit(ap, l, uc, lane, wave);
#endif
        }
        GRID_BAR();
#ifndef NO_G2
        { int kglu = 256; asm volatile("" : "+s"(kglu));
          pg8::Gemm g{(const bf16*)(ws + WS_GBUF), (const bf16*)(ws + WS_GLU) + (size_t)l * 65536, T, 256, kglu}; pg8::StaticOrder S; S.init(T, 256, G, bid);
          pg8::EpiGLU E{(const bf16*)(ws + WS_GBUF), ap->in[I_GLUB] + l * 256, ap->in[I_SSMNW] + l * 256, ymix, D, LN_EPS};
          pg8::gemm_phase<pg8::EpiGLU, pg8::StaticOrder, PG8_ALIGN, PG8_SP2>(lds + RING_OFF, g, S, E); }
#endif
        GRID_BAR();
#ifndef NO_G3
        { pg8::Gemm g{ymix, (const bf16*)(ws + WS_WOUT) + (size_t)l * D * D, T, D, D}; pg8::StaticOrder S; S.init(T, D, G, bid);
          pg8::EpiResF32 E{l == 0 ? ap->in[I_X] : out, out, D, ALPHA};
          pg8::gemm_phase<pg8::EpiResF32, pg8::StaticOrder, PG8_ALIGN, PG8_SP2>(lds + RING_OFF, g, S, E); }
#endif
        GRID_BAR();
        const int li = l >> 1;
        if (l & 1) {
#ifndef NO_LN
            ln_phase<1>(ap, ap->in[I_LNMW] + l * D, ap->in[I_LNMB] + l * D, ap->in[I_ROUTER] + (size_t)li * D * NE, lds, tid, lane, wave);
#endif
            GRID_BAR();
#ifndef NO_LN
            moe_gather_phase(ap, lds, tid, lane, wave);
#endif
            GRID_BAR();
            const int np = (int)__builtin_amdgcn_readfirstlane(__hip_atomic_load((unsigned*)ws + CW_NP, RLX_AGENT));
            const int* panel_exp = (const int*)(ws + WS_MOE + MO_PANEL);
#ifndef NO_G4
            { pg8::Gemm g{(const bf16*)(ws + WS_R1), (const bf16*)(ws + WS_MGU) + (size_t)li * NE * 1536 * 1024, np * 256, 1536, D}; pg8::MoeOrder S{panel_exp, 6, np * 6, G, bid};
              pg8::EpiSwiGLU<true> E{(bf16*)(ws + WS_R2), EFFP, (const float*)(ws + WS_MOE + MO_ROWW)};
              pg8::gemm_phase<pg8::EpiSwiGLU<true>, pg8::MoeOrder, PG8_ALIGN, PG8_SP2>(lds + RING_OFF, g, S, E); }
#endif
            GRID_BAR();
#ifndef NO_G5
            { pg8::Gemm g{(const bf16*)(ws + WS_R2), (const bf16*)(ws + WS_MDN) + (size_t)li * NE * 1024 * EFFP, np * 256, D, EFFP}; pg8::MoeOrder S{panel_exp, 4, np * 4, G, bid};
              pg8::EpiStoreBf16 E{(bf16*)(ws + WS_R1), D};
              pg8::gemm_phase<pg8::EpiStoreBf16, pg8::MoeOrder, PG8_ALIGN, PG8_SP2>(lds + RING_OFF, g, S, E); }
#endif
            GRID_BAR();
#ifndef NO_LN
            ln_phase<2>(ap, ap->in[I_LNFW] + l * D, ap->in[I_LNFB] + l * D, nullptr, lds, tid, lane, wave);
#endif
            GRID_BAR();
        } else {
#ifndef NO_LN
            ln_phase<0>(ap, ap->in[I_LNMW] + l * D, ap->in[I_LNMB] + l * D, nullptr, lds, tid, lane, wave);
#endif
            GRID_BAR();
#ifndef NO_G6
            { pg8::Gemm g{xb, (const bf16*)(ws + WS_FGU) + (size_t)li * 5632 * 1024, T, 5632, D}; pg8::StaticOrder S; S.init(T, 5632, G, bid);
              pg8::EpiSwiGLU<false> E{(bf16*)(ws + WS_R1), DFFP, nullptr};
              pg8::gemm_phase<pg8::EpiSwiGLU<false>, pg8::StaticOrder, PG8_ALIGN, PG8_SP2>(lds + RING_OFF, g, S, E); }
#endif
            GRID_BAR();
#ifndef NO_G7
            { pg8::Gemm g{(const bf16*)(ws + WS_R1), (const bf16*)(ws + WS_FDN) + (size_t)li * 1024 * DFFP, T, D, DFFP}; pg8::StaticOrder S; S.init(T, D, G, bid);
              pg8::EpiResF32 E{out, out, D, ALPHA};
              pg8::gemm_phase<pg8::EpiResF32, pg8::StaticOrder, PG8_ALIGN, PG8_SP2>(lds + RING_OFF, g, S, E); }
#endif
            GRID_BAR();
#ifndef NO_LN
            ln_phase<0>(ap, ap->in[I_LNFW] + l * D, ap->in[I_LNFB] + l * D, nullptr, lds, tid, lane, wave);
#endif
            GRID_BAR();
        }
}

__global__ void __launch_bounds__(NWAVES * 64, 2) hybrid_fwd(Args args) {
    extern __shared__ __attribute__((aligned(16))) unsigned char lds_raw[];
    LAS unsigned char* lds = (LAS unsigned char*)lds_raw;
    int tid, lane, wave, G, bid; ArgsP ap; unsigned char* ws;
    RELAUNDER();
    for (int u = tid; u < (LDS_BYTES - LDSCTL_OFF) / 4; u += NWAVES * 64) ((LAS unsigned*)(lds + LDSCTL_OFF))[u] = 0u;
    __syncthreads();
    XcdBarrier bar = xcd_barrier_post((unsigned*)(ws + WS_CTL) + CW_BAR, (volatile LAS unsigned*)(lds + MISC_OFF) + 8);
#ifndef NO_P0
    p0_prologue(ap, lds, tid, lane, wave);
#endif
    GRID_BAR();
    layer_body<0>(bar, lds); layer_body<1>(bar, lds); layer_body<2>(bar, lds); layer_body<3>(bar, lds);
#undef GRID_BAR
#undef RELAUNDER
#undef LAUNDER_LANE
#undef xb
#undef proj
#undef vT
#undef ymix
#undef out
}

extern "C" void kernel_launch(void* const* d_in, const int* in_sizes, int n_in, void* d_out, int out_size, void* d_ws, size_t ws_size, hipStream_t stream) {
    static int grid = 0;
    if (grid == 0) {
        if (n_in != 28 || out_size != T * D || ws_size < WS_END) { fprintf(stderr, "kernel_launch: unexpected problem shape (n_in %d, out %d, ws %zu); nothing launched\n", n_in, out_size, ws_size); grid = -1; return; }
        int dev = 0, cus = 0, per_cu = 0;
        if (hipGetDevice(&dev) != hipSuccess || hipDeviceGetAttribute(&cus, hipDeviceAttributeMultiprocessorCount, dev) != hipSuccess) { grid = -1; return; }
        if (hipFuncSetAttribute((const void*)hybrid_fwd, hipFuncAttributeMaxDynamicSharedMemorySize, LDS_BYTES) != hipSuccess) { fprintf(stderr, "kernel_launch: hipFuncSetAttribute failed\n"); grid = -1; return; }
        if (hipOccupancyMaxActiveBlocksPerMultiprocessor(&per_cu, (const void*)hybrid_fwd, NWAVES * 64, LDS_BYTES) != hipSuccess || per_cu < 1)
            fprintf(stderr, "kernel_launch: note: occupancy query reports %d workgroups per CU\n", per_cu);
        (void)hipGetLastError();
        grid = cus < 256 ? cus : 256;
    }
    if (grid < 0) return;
    if (hipMemsetAsync((char*)d_ws + WS_CTL, 0, CTL_ZERO_BYTES, stream) != hipSuccess) return;
    Args a{};
    for (int i = 0; i < 28; ++i) a.in[i] = (const float*)d_in[i];
    a.out = (float*)d_out; a.ws = (unsigned char*)d_ws;
    hipLaunchKernelGGL(hybrid_fwd, dim3(grid), dim3(NWAVES * 64), LDS_BYTES, stream, a);
}
```

```cpp
#include <hip/hip_runtime.h>
#include <cstdio>
#include <cstdint>
namespace pg8 {
#define PG8_LAS __attribute__((address_space(3)))
typedef unsigned short bf16_t;
typedef short bf16x8 __attribute__((ext_vector_type(8)));
typedef float f32x4 __attribute__((ext_vector_type(4)));
typedef unsigned u32x4 __attribute__((ext_vector_type(4)));
constexpr int BM = 256, BK = 64, HALF = 128, HTB = HALF * BK * 2  , STAGE_BYTES = 8 * HTB, NXCD = 8, WGM = 8;

__host__ __device__ __forceinline__ int lds_byte(int r, int c) { const int st = (r >> 4) * 2 + (c >> 5), rr = r & 15, cc = c & 31, ob = rr * 64 + cc * 2; return st * 1024 + (ob ^ (((ob >> 9) & 1) << 5)); }
__host__ __device__ __forceinline__ void stage_rc(int b, int& R, int& C) { const int st = b / 1024, sb = b % 1024, swz = sb ^ (((sb >> 9) & 1) << 5); R = (st >> 1) * 16 + swz / 64; C = (st & 1) * 32 + (swz % 64) / 2; }
__host__ __device__ __forceinline__ int perm32(int rho) { const int n = rho >> 4, i = rho & 15; return 8 * (i >> 2) + 4 * n + (i & 3); }

struct Unit { int pm, pn, pb; };
struct Gemm { const bf16_t* A; const bf16_t* Bt; int M, N, K; };

struct StaticOrder {
    int nM, nN, nwg, G, c;
    __host__ __device__ void init(int M, int N, int G_, int c_) { nM = M / BM; nN = N / BM; nwg = nM * nN; G = G_; c = c_; }
    __host__ __device__ bool next(int i, Unit& u) const {
        const long L = (long)i * G + c; if (L >= nwg) return false;
        int wgid = (int)L; { const int q = nwg / NXCD, r = nwg % NXCD, xcd = wgid % NXCD, off = wgid / NXCD; wgid = (xcd < r ? xcd * (q + 1) : r * (q + 1) + (xcd - r) * q) + off; }
        const int nig = WGM * nN, gid = wgid / nig, fm = gid * WGM, gsz = (nM - fm) < WGM ? (nM - fm) : WGM;
        u.pm = fm + ((wgid % nig) % gsz); u.pn = (wgid % nig) / gsz; u.pb = u.pn; return true;
    }
    __device__ __forceinline__ void a_ready(const Unit&) const {}
    __device__ __forceinline__ void done(const Unit&) const {}
};

__device__ __forceinline__ unsigned cvt_pk_bf16(float lo, float hi) { unsigned r; asm volatile("v_cvt_pk_bf16_f32 %0, %1, %2" : "=v"(r) : "v"(lo), "v"(hi)); return r; }
typedef float f32x2 __attribute__((ext_vector_type(2)));
__device__ __forceinline__ f32x2 gelu_pk(f32x2 v) {
    const f32x2 av = __builtin_elementwise_abs(v), d = av * 0.2316418882f + 1.0f;
    f32x2 t; t.x = __builtin_amdgcn_rcpf(d.x); t.y = __builtin_amdgcn_rcpf(d.y);
    f32x2 q = t * 0.5307027145f + (-0.7265760135f); q = q * t + 0.7107068705f; q = q * t + (-0.142248368f); q = q * t + 0.127414796f; q = q * t;
    const f32x2 s = (v * v) * (-0.72134752044f);
    f32x2 e; e.x = __builtin_amdgcn_exp2f(s.x); e.y = __builtin_amdgcn_exp2f(s.y);
    const f32x2 m = v * (q * e), r = v - m;
    f32x2 o; o.x = v.x < 0.f ? m.x : r.x; o.y = v.y < 0.f ? m.y : r.y; return o;
}

__device__ __forceinline__ float fast_silu(float x) { return x * __builtin_amdgcn_rcpf(1.0f + __expf(-x)); }
__device__ __forceinline__ float bf2f(unsigned short b) { return __uint_as_float(((unsigned)b) << 16); }

struct EpiStoreBf16 {
    static constexpr bool PERM = true, AFTER_DRAIN = false;
    bf16_t* O; int ldc;
    __device__ __forceinline__ void operator()(const f32x4 (&acc)[2][2][4][2], const Unit& u, int wr, int wc, int fr, int fq) const {
        const int row0 = u.pm * BM + wr * 64 + fr, col0 = u.pn * BM + wc * 32 + 8 * fq;
#pragma unroll
        for (int ai = 0; ai < 2; ++ai)
#pragma unroll
            for (int m = 0; m < 4; ++m) { bf16_t* rowp = O + (size_t)(row0 + ai * HALF + m * 16) * ldc + col0;
#pragma unroll
                for (int bj = 0; bj < 2; ++bj) { const f32x4 v0 = acc[ai][bj][m][0], v1 = acc[ai][bj][m][1];
                    u32x4 w; w.x = cvt_pk_bf16(v0[0], v0[1]); w.y = cvt_pk_bf16(v0[2], v0[3]); w.z = cvt_pk_bf16(v1[0], v1[1]); w.w = cvt_pk_bf16(v1[2], v1[3]);
                    *(u32x4*)(rowp + bj * HALF) = w; } }
    }
};
struct EpiResF32 {
    static constexpr bool PERM = false, AFTER_DRAIN = false;
    const float* src; float* dst; int ldc; float alpha;
    __device__ __forceinline__ void operator()(const f32x4 (&acc)[2][2][4][2], const Unit& u, int wr, int wc, int fr, int fq) const {
        const int row0 = u.pm * BM + wr * 64 + fr, col0 = u.pn * BM + wc * 32 + 4 * fq;
#pragma unroll
        for (int ai = 0; ai < 2; ++ai)
#pragma unroll
            for (int m = 0; m < 4; ++m) { const size_t ro = (size_t)(row0 + ai * HALF + m * 16) * ldc + col0;
#pragma unroll
                for (int bj = 0; bj < 2; ++bj)
#pragma unroll
                    for (int n = 0; n < 2; ++n) { const f32x4 s = *(const f32x4*)(src + ro + bj * HALF + n * 16); *(f32x4*)(dst + ro + bj * HALF + n * 16) = s * alpha + acc[ai][bj][m][n]; } }
    }
};
template <bool ROWW> struct EpiSwiGLU {
    static constexpr bool PERM = true, AFTER_DRAIN = false;
    bf16_t* H; int ldh; const float* roww;
    __device__ __forceinline__ void operator()(const f32x4 (&acc)[2][2][4][2], const Unit& u, int wr, int wc, int fr, int fq) const {
        const int row0 = u.pm * BM + wr * 64 + fr, col0 = u.pn * HALF + wc * 32 + 8 * fq;
#pragma unroll
        for (int ai = 0; ai < 2; ++ai)
#pragma unroll
            for (int m = 0; m < 4; ++m) { const int row = row0 + ai * HALF + m * 16; const float rw = ROWW ? roww[row] : 1.0f;
                float h[8];
#pragma unroll
                for (int n = 0; n < 2; ++n)
#pragma unroll
                    for (int j = 0; j < 4; ++j) h[4 * n + j] = fast_silu(acc[ai][0][m][n][j]) * acc[ai][1][m][n][j] * rw;
                u32x4 w; w.x = cvt_pk_bf16(h[0], h[1]); w.y = cvt_pk_bf16(h[2], h[3]); w.z = cvt_pk_bf16(h[4], h[5]); w.w = cvt_pk_bf16(h[6], h[7]);
                *(u32x4*)(H + (size_t)row * ldh + col0) = w; }
    }
};
struct EpiGLU {
    static constexpr bool PERM = true, AFTER_DRAIN = false;
    const bf16_t* G; const float* glu_b; const float* norm_w; bf16_t* Y; int ldy; float eps;
    __device__ __forceinline__ void operator()(const f32x4 (&acc)[2][2][4][2], const Unit& u, int wr, int wc, int fr, int fq) const {
        const int row0 = u.pm * BM + wr * 64 + fr, col0 = wc * 32 + 8 * fq;
        const bf16_t* G = this->G; const float* glu_b = this->glu_b; const float* norm_w = this->norm_w; bf16_t* Y = this->Y;
        asm volatile("" : "+s"(G), "+s"(glu_b), "+s"(norm_w), "+s"(Y));
#pragma unroll
        for (int bj = 0; bj < 2; ++bj) { const int col = col0 + bj * HALF;
            const f32x4 b0 = *(const f32x4*)(glu_b + col), b1 = *(const f32x4*)(glu_b + col + 4), n0 = *(const f32x4*)(norm_w + col), n1 = *(const f32x4*)(norm_w + col + 4);
#pragma unroll
            for (int ai = 0; ai < 2; ++ai)
#pragma unroll
                for (int m = 0; m < 4; ++m) { const int row = row0 + ai * HALF + m * 16;
                    const u32x4 gr = *(const u32x4*)(G + (size_t)row * 256 + col);
                    float gv[8]; gv[0] = __uint_as_float(gr.x << 16); gv[1] = __uint_as_float(gr.x & 0xffff0000u); gv[2] = __uint_as_float(gr.y << 16); gv[3] = __uint_as_float(gr.y & 0xffff0000u);
                    gv[4] = __uint_as_float(gr.z << 16); gv[5] = __uint_as_float(gr.z & 0xffff0000u); gv[6] = __uint_as_float(gr.w << 16); gv[7] = __uint_as_float(gr.w & 0xffff0000u);
                    float o[8]; float ss = 0.f;
#pragma unroll
                    for (int j = 0; j < 4; ++j) { const float z0 = acc[ai][bj][m][0][j] + b0[j], z1 = acc[ai][bj][m][1][j] + b1[j];
                        o[j] = gv[j] * __builtin_amdgcn_rcpf(1.0f + __expf(-z0)); o[4 + j] = gv[4 + j] * __builtin_amdgcn_rcpf(1.0f + __expf(-z1)); ss += o[j] * o[j] + o[4 + j] * o[4 + j]; }
                    ss += __shfl_xor(ss, 16);
                    const float r = __builtin_amdgcn_rsqf(ss * (1.0f / 16.0f) + eps);
                    u32x4 w; w.x = cvt_pk_bf16(o[0] * r * n0[0], o[1] * r * n0[1]); w.y = cvt_pk_bf16(o[2] * r * n0[2], o[3] * r * n0[3]);
                    w.z = cvt_pk_bf16(o[4] * r * n1[0], o[5] * r * n1[1]); w.w = cvt_pk_bf16(o[6] * r * n1[2], o[7] * r * n1[3]);
                    *(u32x4*)(Y + (size_t)row * ldy + col) = w; asm volatile("" ::: "memory"); } }
    }
};
struct MoeOrder {
    const int* panel_exp; int NT, nunits, G, c;
    __device__ __forceinline__ bool next(int i, Unit& u) const {
        const int L = i * G + c; if (L >= nunits) return false;
        const int p = L / NT, t = L - p * NT; u.pm = p; u.pn = t; u.pb = __builtin_amdgcn_readfirstlane(panel_exp[p]) * NT + t; return true;
    }
    __device__ __forceinline__ void a_ready(const Unit&) const {}
    __device__ __forceinline__ void done(const Unit&) const {}
};

template <class Epi, class Sched, bool ALIGN_EPI = false, bool SP2 = false>
__device__ __forceinline__ void gemm_phase(PG8_LAS unsigned char* lds, const Gemm g, const Sched& S, const Epi& E) {
    int tid_o = threadIdx.x; asm volatile("" : "+v"(tid_o));
    const int tid = tid_o, wid = __builtin_amdgcn_readfirstlane(tid >> 6), lane = tid & 63, wr = wid >> 2, wc = wid & 3, fr = lane & 15, fq = lane >> 4;
    const int K = g.K, nt = K / BK;
    unsigned voffA[2], voffB[2];
#pragma unroll
    for (int i = 0; i < 2; ++i) { int R, C; stage_rc(tid * 16 + i * 8192, R, C); const int Rb = Epi::PERM ? ((R & ~31) + perm32(R & 31)) : R;
        voffA[i] = (unsigned)(R * K + C) * 2u; voffB[i] = (unsigned)(Rb * K + C) * 2u; }
    const size_t kstep = (size_t)(BK * 2);
    const size_t hstep = (size_t)HALF * K * 2;
    const size_t tstep = 2 * hstep;
    const unsigned ldsw = (unsigned)wid * 1024u;
    const int aoff = lds_byte(wr * 64 + fr, fq * 8), boff = lds_byte(wc * 32 + fr, fq * 8);
#define PG8_SA(b, h) (((b) * 2 + (h)) * HTB)
#define PG8_SB(b, h) ((4 + (b) * 2 + (h)) * HTB)
#define PG8_STAGE(bufoff, gbase, voff) do { _Pragma("unroll") for (int _i = 0; _i < 2; ++_i) \
        __builtin_amdgcn_global_load_lds((const unsigned*)((const char*)(gbase) + (voff)[_i]), (PG8_LAS unsigned*)(lds + (bufoff) + ldsw + _i * 8192), 16, 0, 0); } while (0)
#define PG8_LDA(dst, b, h) do { _Pragma("unroll") for (int m = 0; m < 4; ++m) _Pragma("unroll") for (int k = 0; k < 2; ++k) dst[m][k] = *(const PG8_LAS bf16x8*)(lds + PG8_SA(b, h) + aoff + m * 2048 + k * 1024); } while (0)
#define PG8_LDB(dst, b, h) do { _Pragma("unroll") for (int n = 0; n < 2; ++n) _Pragma("unroll") for (int k = 0; k < 2; ++k) dst[n][k] = *(const PG8_LAS bf16x8*)(lds + PG8_SB(b, h) + boff + n * 2048 + k * 1024); } while (0)
#define PG8_MMA(ai, bj, At, Bt) do { __builtin_amdgcn_s_setprio(1); _Pragma("unroll") for (int m = 0; m < 4; ++m) _Pragma("unroll") for (int n = 0; n < 2; ++n) _Pragma("unroll") for (int k = 0; k < 2; ++k) \
        acc[ai][bj][m][n] = __builtin_amdgcn_mfma_f32_16x16x32_bf16(Bt[n][k], At[m][k], acc[ai][bj][m][n], 0, 0, 0); __builtin_amdgcn_s_setprio(0); } while (0)
#define PG8_WAIT_V(n) asm volatile("s_waitcnt vmcnt(" #n ")" ::: "memory")
#define PG8_WAIT_L(n) asm volatile("s_waitcnt lgkmcnt(" #n ")" ::: "memory")
#define PG8_BAR __builtin_amdgcn_s_barrier()
#define PG8_SCHED __builtin_amdgcn_sched_barrier(0)
    Unit cur, nxt; int ui = 0;
    if (!S.next(0, cur)) return;
    f32x4 acc[2][2][4][2];
#pragma unroll
    for (int a = 0; a < 2; ++a)
#pragma unroll
        for (int b = 0; b < 2; ++b)
#pragma unroll
            for (int m = 0; m < 4; ++m)
#pragma unroll
                for (int n = 0; n < 2; ++n) acc[a][b][m][n] = (f32x4){0.f, 0.f, 0.f, 0.f};
    bf16x8 At[4][2], B0[2][2], B1[2][2];
    const char* cA = (const char*)g.A + (size_t)cur.pm * tstep; const char* cB = (const char*)g.Bt + (size_t)cur.pb * tstep;
    S.a_ready(cur);
    if constexpr (SP2) {
        PG8_STAGE(PG8_SB(0, 0), cB, voffB); PG8_STAGE(PG8_SB(0, 1), cB + hstep, voffB); PG8_STAGE(PG8_SA(0, 0), cA, voffA); PG8_STAGE(PG8_SA(0, 1), cA + hstep, voffA);
        if (wr == 1) PG8_BAR;
        PG8_WAIT_V(2); PG8_BAR;
        PG8_STAGE(PG8_SB(1, 0), cB + kstep, voffB); PG8_STAGE(PG8_SA(1, 0), cA + kstep, voffA); PG8_STAGE(PG8_SB(1, 1), cB + hstep + kstep, voffB);
        PG8_WAIT_V(6); PG8_BAR;
    } else {
        PG8_STAGE(PG8_SB(0, 0), cB, voffB); PG8_STAGE(PG8_SA(0, 0), cA, voffA); PG8_STAGE(PG8_SB(0, 1), cB + hstep, voffB); PG8_STAGE(PG8_SA(0, 1), cA + hstep, voffA);
        if (wr == 1) PG8_BAR;
        PG8_WAIT_V(4); PG8_BAR;
        PG8_STAGE(PG8_SB(1, 0), cB + kstep, voffB); PG8_STAGE(PG8_SA(1, 0), cA + kstep, voffA); PG8_STAGE(PG8_SB(1, 1), cB + hstep + kstep, voffB);
        PG8_WAIT_V(6); PG8_BAR;
    }
    for (;;) {
        const bool has_next = S.next(ui + 1, nxt);
        const char* nA = has_next ? (const char*)g.A + (size_t)nxt.pm * tstep : cA; const char* nB = has_next ? (const char*)g.Bt + (size_t)nxt.pb * tstep : cB;
        for (int t = 0; t < nt; t += 2) {
            const bool last = (t == nt - 2);
            const char* a1 = cA + (size_t)(t + 1) * kstep;
            const char* a2 = last ? nA : cA + (size_t)(t + 2) * kstep; const char* b2 = last ? nB : cB + (size_t)(t + 2) * kstep;
            const char* a3 = a2 + kstep; const char* b3 = b2 + kstep;
            if (last && has_next) S.a_ready(nxt);
            if constexpr (SP2) {
            PG8_LDB(B0, 0, 0); PG8_LDB(B1, 0, 1); PG8_SCHED; PG8_LDA(At, 0, 0); PG8_STAGE(PG8_SA(1, 1), a1 + hstep, voffA);
            PG8_WAIT_V(8); PG8_WAIT_L(0); PG8_BAR; PG8_MMA(0, 0, At, B0); PG8_MMA(0, 1, At, B1); PG8_BAR; PG8_SCHED;
            PG8_LDA(At, 0, 1); PG8_STAGE(PG8_SB(0, 0), b2, voffB); PG8_STAGE(PG8_SB(0, 1), b2 + hstep, voffB); PG8_STAGE(PG8_SA(0, 0), a2, voffA);
            PG8_WAIT_V(8); PG8_WAIT_L(0); PG8_BAR; PG8_MMA(1, 0, At, B0); PG8_MMA(1, 1, At, B1); PG8_BAR; PG8_SCHED;
            PG8_LDB(B0, 1, 0); PG8_LDB(B1, 1, 1); PG8_SCHED; PG8_LDA(At, 1, 0); PG8_STAGE(PG8_SA(0, 1), a2 + hstep, voffA);
            PG8_WAIT_V(8); PG8_WAIT_L(0); PG8_BAR; PG8_MMA(0, 0, At, B0); PG8_MMA(0, 1, At, B1); PG8_BAR; PG8_SCHED;
            PG8_LDA(At, 1, 1); PG8_STAGE(PG8_SB(1, 0), b3, voffB); PG8_STAGE(PG8_SB(1, 1), b3 + hstep, voffB); PG8_STAGE(PG8_SA(1, 0), a3, voffA);
            PG8_WAIT_V(8); PG8_WAIT_L(0); PG8_BAR; PG8_MMA(1, 0, At, B0); PG8_MMA(1, 1, At, B1); PG8_BAR; PG8_SCHED;
            } else {
            PG8_LDB(B0, 0, 0); PG8_SCHED; PG8_LDA(At, 0, 0); PG8_STAGE(PG8_SA(1, 1), a1 + hstep, voffA);
            PG8_WAIT_L(8); PG8_BAR; PG8_WAIT_L(0); PG8_MMA(0, 0, At, B0); PG8_BAR; PG8_SCHED;
            PG8_LDB(B1, 0, 1); PG8_STAGE(PG8_SB(0, 0), b2, voffB);
            PG8_BAR; PG8_WAIT_L(0); PG8_MMA(0, 1, At, B1); PG8_BAR;
            PG8_LDA(At, 0, 1); PG8_STAGE(PG8_SA(0, 0), a2, voffA);
            PG8_BAR; PG8_WAIT_L(0); PG8_MMA(1, 0, At, B0); PG8_BAR; PG8_SCHED;
            PG8_STAGE(PG8_SB(0, 1), b2 + hstep, voffB);
            PG8_WAIT_V(6); PG8_BAR; PG8_MMA(1, 1, At, B1); PG8_BAR;
            PG8_LDB(B0, 1, 0); PG8_SCHED; PG8_LDA(At, 1, 0); PG8_STAGE(PG8_SA(0, 1), a2 + hstep, voffA);
            PG8_WAIT_L(8); PG8_BAR; PG8_WAIT_L(0); PG8_MMA(0, 0, At, B0); PG8_BAR; PG8_SCHED;
            PG8_LDB(B1, 1, 1); PG8_STAGE(PG8_SB(1, 0), b3, voffB);
            PG8_BAR; PG8_WAIT_L(0); PG8_MMA(0, 1, At, B1); PG8_BAR;
            PG8_LDA(At, 1, 1); PG8_STAGE(PG8_SA(1, 0), a3, voffA);
            PG8_BAR; PG8_WAIT_L(0); PG8_MMA(1, 0, At, B0); PG8_BAR; PG8_SCHED;
            PG8_STAGE(PG8_SB(1, 1), b3 + hstep, voffB);
            PG8_WAIT_V(6); PG8_BAR; PG8_MMA(1, 1, At, B1); PG8_BAR;
            }
        }
        if constexpr (ALIGN_EPI) { if (wr == 0) PG8_BAR; }
        if constexpr (!Epi::AFTER_DRAIN) { E(acc, cur, wr, wc, fr, fq); S.done(cur); }
        if (!has_next) break;
#pragma unroll
        for (int a = 0; a < 2; ++a)
#pragma unroll
            for (int b = 0; b < 2; ++b)
#pragma unroll
                for (int m = 0; m < 4; ++m)
#pragma unroll
                    for (int n = 0; n < 2; ++n) acc[a][b][m][n] = (f32x4){0.f, 0.f, 0.f, 0.f};
        cur = nxt; cA = nA; cB = nB; ++ui;
        if constexpr (ALIGN_EPI) { if (wr == 1) PG8_BAR; }
    }
    PG8_WAIT_V(0);
    if constexpr (!ALIGN_EPI) { if (wr == 0) PG8_BAR; }
    PG8_BAR;
    if constexpr (Epi::AFTER_DRAIN) { E.fused(acc, cur, wr, wc, fr, fq, lds, wid, lane); S.done(cur); }
#undef PG8_SA
#undef PG8_SB
#undef PG8_STAGE
#undef PG8_LDA
#undef PG8_LDB
#undef PG8_MMA
#undef PG8_WAIT_V
#undef PG8_WAIT_L
#undef PG8_BAR
#undef PG8_SCHED
}
}
#define PG8_SP2 true
#define PG8_ALIGN true

constexpr int BATCH = 2, SEQ = 16384, T = BATCH * SEQ, D = 1024, DEPTH = 4;
constexpr int NPROJ = 2304, NVT = 768;
constexpr int PC_U = 0, PC_RQ = 256, PC_RK = 768, PC_RG = 1280, PC_SQ = 1792, PC_SK = 2048, VT_RV = 0, VT_SV = 512;
constexpr int DFF = 2752, DFFP = 2816, EFF = 688, EFFP = 768, NE = 8;
constexpr int CH = 128, NUC = T / CH;
constexpr int MAXPAN = 264, MAXROWS = MAXPAN * 256;
constexpr float ALPHA = 1.6817928305074290f, LN_EPS = 1e-5f;
constexpr float SB_THR = 30.0f;

constexpr size_t MiB = 1u << 20;
constexpr size_t WS_CTL = 0, CTL_ZERO_BYTES = 1 * MiB;
constexpr size_t WS_WIN = 1 * MiB, WS_WOUT = 25 * MiB, WS_FGU = 33 * MiB, WS_FDN = 55 * MiB, WS_MGU = 66 * MiB, WS_MDN = 114 * MiB, WS_GLU = 138 * MiB;
constexpr size_t WS_ROPE = 139 * MiB;
constexpr size_t WS_S5LOC = 143 * MiB, WS_S5CAR = 145 * MiB;
constexpr size_t WS_MOE = 147 * MiB;
constexpr size_t MO_S5TAB = 1792 * 1024, MO_RETLG = 1920 * 1024;
constexpr size_t MO_SELE = 0, MO_SELR = 128 * 1024, MO_SELW = 256 * 1024, MO_TOKPOS = 512 * 1024, MO_ROWW = 768 * 1024, MO_COUNTS = 1280 * 1024, MO_PANEL = 1536 * 1024;
constexpr size_t WS_R1 = 149 * MiB;
constexpr size_t WS_VT = WS_R1 + 144 * MiB;
constexpr size_t WS_R2 = 341 * MiB;
constexpr size_t WS_RETLOC = WS_R2, WS_RETPREV = WS_R2 + 32 * MiB, WS_GBUF = WS_R2 + 48 * MiB;
constexpr size_t WS_R3 = 405 * MiB;
constexpr size_t WS_END = 469 * MiB;
static_assert((size_t)MAXROWS * EFFP * 2 <= 128 * MiB && (size_t)MAXROWS * 1024 * 2 <= 192 * MiB && (size_t)T * DFFP * 2 <= 192 * MiB, "overlay sizes");
constexpr int CW_TMO = 0, CW_NP = 64, CW_BAR = 4096;

constexpr int RING_OFF = 0, RING_BYTES = 131072;
constexpr int LDSCTL_OFF = 146432, MISC_OFF = LDSCTL_OFF + 320;
constexpr int LDS_BYTES = 147456;
constexpr int NWAVES = 8;

#define GAS __attribute__((address_space(1)))
#define LAS __attribute__((address_space(3)))
typedef unsigned short bf16;
typedef unsigned u32x4 __attribute__((ext_vector_type(4)));
typedef unsigned u32x2 __attribute__((ext_vector_type(2)));
typedef float f32x4 __attribute__((ext_vector_type(4)));
typedef float f32x2 __attribute__((ext_vector_type(2)));
typedef float f32x16 __attribute__((ext_vector_type(16)));
typedef short bf16x8 __attribute__((ext_vector_type(8)));
typedef GAS unsigned gu32;
#define RLX_AGENT __ATOMIC_RELAXED, __HIP_MEMORY_SCOPE_AGENT
#define LDS_WAIT() asm volatile("s_waitcnt lgkmcnt(0)" ::: "memory")
#define VM_WAIT() asm volatile("s_waitcnt vmcnt(0)" ::: "memory")

#define XB_TMO      128
#define XB_XCNT(j)  (256  + 64 * (j))
#define XB_XSUB(j)  (1280 + 64 * (j))
#define XB_XGEN(j)  (2304 + 64 * (j))
#define XB_TOP      3328
#define XB_TOPGEN   3392
#define XCD_BAR_WORDS 3456
#define XB_SPIN_CAP (1u << 18)

__device__ __forceinline__ unsigned xb_ld(unsigned* p)              { return __hip_atomic_load(p, __ATOMIC_RELAXED, __HIP_MEMORY_SCOPE_AGENT); }
__device__ __forceinline__ unsigned xb_add(unsigned* p, unsigned v) { return __hip_atomic_fetch_add(p, v, __ATOMIC_RELAXED, __HIP_MEMORY_SCOPE_AGENT); }
__device__ __forceinline__ unsigned xb_xcc_id() { return (unsigned)__builtin_amdgcn_s_getreg((3 << 11) | 20) & 0xFu; }
#define XB_SPIN(cond, bar) do { unsigned _sp = 0; while (cond) { __builtin_amdgcn_s_sleep(1); \
    if ((++_sp & 255u) == 0u) { if (xb_ld(&(bar)[XB_TMO])) break; if (_sp > XB_SPIN_CAP) { atomicAdd(&(bar)[XB_TMO], 1u); break; } } } } while (0)

struct XcdBarrier {
    unsigned* bar; unsigned x;
    volatile LAS unsigned* st;
};

__device__ __forceinline__ XcdBarrier xcd_barrier_post(unsigned* bar, volatile LAS unsigned* st) {
    XcdBarrier b; b.bar = bar; b.x = xb_xcc_id(); b.st = st;
    if (threadIdx.x == 0) (void)xb_add(&bar[XB_XCNT(b.x)], 1u);
    return b;
}
__device__ __forceinline__ void xcd_barrier_complete(unsigned* bar, unsigned x, unsigned& nloc, unsigned& nx) {
    const unsigned G = gridDim.x * gridDim.y * gridDim.z;
    unsigned sum, cnt, mine, sp = 0u;
    for (;;) {
        sum = 0u; cnt = 0u; mine = 0u;
#pragma unroll
        for (unsigned j = 0; j < 16; ++j) { const unsigned c = xb_ld(&bar[XB_XCNT(j)]); sum += c; cnt += (c > 0u) ? 1u : 0u; mine = (j == x) ? c : mine; }
        if (sum == G) break;
        __builtin_amdgcn_s_sleep(1);
        if ((++sp & 255u) == 0u) { if (xb_ld(&bar[XB_TMO])) break; if (sp > XB_SPIN_CAP) { atomicAdd(&bar[XB_TMO], 1u); break; } }
    }
    nloc = mine > 0u ? mine : 1u; nx = cnt > 0u ? cnt : 1u;
}

__device__ __forceinline__ void xcd_barrier(const XcdBarrier& b) {
    asm volatile("s_waitcnt vmcnt(0)" ::: "memory");
    __syncthreads();
    if (threadIdx.x == 0) {
        unsigned* bar = b.bar; asm volatile("" : "+s"(bar));
        __builtin_amdgcn_s_waitcnt(0);
        unsigned nloc = b.st[0], nx = b.st[1];
        if (nloc == 0u) { xcd_barrier_complete(bar, b.x, nloc, nx); b.st[0] = nloc; b.st[1] = nx; }
        const unsigned old = xb_add(&bar[XB_XSUB(b.x)], 1u);
        const unsigned gen = old / nloc;
        if (old + 1u == (gen + 1u) * nloc) {
            __builtin_amdgcn_fence(__ATOMIC_RELEASE, "agent");
            asm volatile("s_waitcnt vmcnt(0)" ::: "memory");
            const unsigned og = xb_add(&bar[XB_TOP], 1u);
            const unsigned tg = og / nx;
            if (og + 1u == (tg + 1u) * nx) xb_add(&bar[XB_TOPGEN], 1u);
            else XB_SPIN(xb_ld(&bar[XB_TOPGEN]) == tg, bar);
            __builtin_amdgcn_fence(__ATOMIC_ACQUIRE, "agent");
            xb_add(&bar[XB_XGEN(b.x)], 1u);
            asm volatile("s_waitcnt vmcnt(0)" ::: "memory");
        } else {
            XB_SPIN(xb_ld(&bar[XB_XGEN(b.x)]) == gen, bar);
            __builtin_amdgcn_fence(__ATOMIC_ACQUIRE, "agent");
            asm volatile("s_waitcnt vmcnt(0)" ::: "memory");
        }
    }
    __syncthreads();
}

__device__ __forceinline__ float bf2f(unsigned short b) { return __uint_as_float(((unsigned)b) << 16); }
__device__ __forceinline__ unsigned cvtpk(float lo, float hi) { return pg8::cvt_pk_bf16(lo, hi); }
__device__ __forceinline__ float wave_sum(float v) {
#pragma unroll
    for (int o = 1; o < 64; o <<= 1) v += __shfl_xor(v, o);
    return v;
}
__device__ __forceinline__ int wave_sum_i(int v) {
#pragma unroll
    for (int o = 1; o < 64; o <<= 1) v += __shfl_xor(v, o);
    return v;
}
__device__ __forceinline__ bf16x8 ld8(const bf16* p) { return __builtin_bit_cast(bf16x8, *(const u32x4*)p); }
__device__ __forceinline__ bf16x8 pack8(const float* a) { u32x4 w; w.x = cvtpk(a[0], a[1]); w.y = cvtpk(a[2], a[3]); w.z = cvtpk(a[4], a[5]); w.w = cvtpk(a[6], a[7]); return __builtin_bit_cast(bf16x8, w); }
__device__ __forceinline__ void unpack8(const u32x4 r, float* o) {
    o[0] = __uint_as_float(r.x << 16); o[1] = __uint_as_float(r.x & 0xffff0000u); o[2] = __uint_as_float(r.y << 16); o[3] = __uint_as_float(r.y & 0xffff0000u);
    o[4] = __uint_as_float(r.z << 16); o[5] = __uint_as_float(r.z & 0xffff0000u); o[6] = __uint_as_float(r.w << 16); o[7] = __uint_as_float(r.w & 0xffff0000u);
}
__device__ __forceinline__ int tau(int r) { return 16 * ((r >> 2) & 1) + 4 * (r >> 3) + (r & 3); }
#define MFMA32(a, b, c) __builtin_amdgcn_mfma_f32_32x32x16_bf16(a, b, c, 0, 0, 0)
#define MFMA16(a, b, c) __builtin_amdgcn_mfma_f32_16x16x32_bf16(a, b, c, 0, 0, 0)
__device__ __forceinline__ float gelu_tanh(float x) {
    const float a = 0.7978845608028654f * (x + 0.044715f * x * x * x);
    const float th = 1.0f - 2.0f * __builtin_amdgcn_rcpf(1.0f + __expf(2.0f * a));
    return 0.5f * x * (1.0f + th);
}

struct Args { const float* in[28]; float* out; unsigned char* ws; };
typedef const __attribute__((address_space(4))) Args* ArgsP;
enum { I_X = 0, I_WIN, I_LAMRE, I_LAMIM, I_LOGDT, I_BRE, I_BIM, I_CRE, I_CIM, I_SSMD, I_GLUW, I_GLUB, I_SSMNW, I_RETGW, I_RETGB, I_SBNW, I_WOUT, I_LNMW, I_LNMB,
       I_FG, I_FU, I_FD, I_ROUTER, I_MG, I_MU, I_MD, I_LNFW, I_LNFB };

__device__ __forceinline__ void tr_item(const float* W, int Ks, int Ns, bf16* WT, int Kd, int k0, int n0, int drow0, LAS float* scr, int lane) {
    float tv[32];
#pragma unroll
    for (int i = 0; i < 32; ++i) { const int kk = 2 * i + (lane >> 5), k = k0 + kk, n = n0 + (lane & 31); tv[i] = (k < Ks && n < Ns) ? W[(size_t)k * Ns + n] : 0.f; }
#pragma unroll
    for (int i = 0; i < 32; ++i) scr[(2 * i + (lane >> 5)) * 33 + (lane & 31)] = tv[i];
    LDS_WAIT(); asm volatile("" ::: "memory");
    const int c = lane & 7;
#pragma unroll
    for (int j = 0; j < 4; ++j) { const int n = (lane >> 3) + 8 * j; const LAS float* s = scr + (8 * c) * 33 + n;
        u32x4 o; o.x = cvtpk(s[0 * 33], s[1 * 33]); o.y = cvtpk(s[2 * 33], s[3 * 33]); o.z = cvtpk(s[4 * 33], s[5 * 33]); o.w = cvtpk(s[6 * 33], s[7 * 33]);
        *(u32x4*)(WT + (size_t)(drow0 + n) * Kd + k0 + 8 * c) = o; }
    LDS_WAIT(); asm volatile("" ::: "memory");
}
__device__ __forceinline__ void p0_prologue(ArgsP a, LAS unsigned char* lds, int tid, int lane, int wave) {
    unsigned char* ws = a->ws;
    LAS float* scr = (LAS float*)(lds + wave * 16384);
    const int gw = blockIdx.x * NWAVES + wave, NGW = gridDim.x * NWAVES;
    constexpr int NA = 4 * 1536, NB = 4 * 512, NC = 2 * 2816, ND = 2 * 1408, NEE = 16 * 768, NF = 16 * 384, NG = 4 * 32;
    constexpr int NITEMS = NA + NB + NC + ND + NEE + NF + NG;
    for (int it = gw; it < NITEMS; it += NGW) {
        int r = it;
        if (r < NA) { const int l = r / 1536, q = r % 1536, kb = q / 96, nb = q % 96, c = 32 * nb;
            const int drow = c < 1280 ? c : (c < 1792 ? 2304 + (c - 1280) : (c < 2816 ? c - 512 : c));
            tr_item(a->in[I_WIN] + (size_t)l * 1024 * 3072, 1024, 3072, (bf16*)(ws + WS_WIN) + (size_t)l * 3072 * 1024, 1024, 64 * kb, c, drow, scr, lane); continue; }
        r -= NA;
        if (r < NB) { const int l = r / 512, q = r % 512, kb = q / 32, nb = q % 32;
            tr_item(a->in[I_WOUT] + (size_t)l * 1024 * 1024, 1024, 1024, (bf16*)(ws + WS_WOUT) + (size_t)l * 1024 * 1024, 1024, 64 * kb, 32 * nb, 32 * nb, scr, lane); continue; }
        r -= NB;
        if (r < NC) { const int li = r / 2816, q = r % 2816, db = q / 16, kb = q % 16, pn = db >> 3, wi = db & 7, ffc = 128 * pn + 32 * (wi & 3);
            const float* src = (wi >> 2) ? a->in[I_FU] : a->in[I_FG];
            tr_item(src + (size_t)li * 1024 * DFF, 1024, DFF, (bf16*)(ws + WS_FGU) + (size_t)li * 5632 * 1024, 1024, 64 * kb, ffc, 32 * db, scr, lane); continue; }
        r -= NC;
        if (r < ND) { const int li = r / 1408, q = r % 1408, kb = q / 32, nb = q % 32;
            tr_item(a->in[I_FD] + (size_t)li * DFF * 1024, DFF, 1024, (bf16*)(ws + WS_FDN) + (size_t)li * 1024 * DFFP, DFFP, 64 * kb, 32 * nb, 32 * nb, scr, lane); continue; }
        r -= ND;
        if (r < NEE) { const int le = r / 768, q = r % 768, db = q / 16, kb = q % 16, pn = db >> 3, wi = db & 7, ffc = 128 * pn + 32 * (wi & 3);
            const float* src = (wi >> 2) ? a->in[I_MU] : a->in[I_MG];
            tr_item(src + (size_t)le * 1024 * EFF, 1024, EFF, (bf16*)(ws + WS_MGU) + (size_t)le * 1536 * 1024, 1024, 64 * kb, ffc, 32 * db, scr, lane); continue; }
        r -= NEE;
        if (r < NF) { const int le = r / 384, q = r % 384, kb = q / 32, nb = q % 32;
            tr_item(a->in[I_MD] + (size_t)le * EFF * 1024, EFF, 1024, (bf16*)(ws + WS_MDN) + (size_t)le * 1024 * EFFP, EFFP, 64 * kb, 32 * nb, 32 * nb, scr, lane); continue; }
        r -= NF;
        { const int l = r / 32, q = r % 32, kb = q / 8, nb = q % 8;
            tr_item(a->in[I_GLUW] + (size_t)l * 65536, 256, 256, (bf16*)(ws + WS_GLU) + (size_t)l * 65536, 256, 64 * kb, 32 * nb, 32 * nb, scr, lane); }
    }
    { const f32x4* x4 = (const f32x4*)a->in[I_X]; u32x4* o = (u32x4*)(ws + WS_R2);
      const size_t n8 = (size_t)T * D / 8, gt = (size_t)blockIdx.x * (NWAVES * 64) + tid, GT = (size_t)gridDim.x * NWAVES * 64;
      for (size_t i = gt; i < n8; i += GT) { const f32x4 v0 = x4[2 * i], v1 = x4[2 * i + 1]; u32x4 w; w.x = cvtpk(v0[0], v0[1]); w.y = cvtpk(v0[2], v0[3]); w.z = cvtpk(v1[0], v1[1]); w.w = cvtpk(v1[2], v1[3]); o[i] = w; } }
    { float* tab = (float*)(ws + WS_MOE + MO_S5TAB);
      const int gt = blockIdx.x * (NWAVES * 64) + tid, GT = gridDim.x * NWAVES * 64;
      for (int i = gt; i < DEPTH * 16 * 64; i += GT) { const int lg = i >> 6;
          const float lr = a->in[I_LAMRE][i], li = a->in[I_LAMIM][i], dt = expf(a->in[I_LOGDT][lg]);
          const float zr = lr * dt, zi = li * dt; float sn, cs; sincosf(zi, &sn, &cs);
          const float mag = expf(zr), ar = mag * cs, ai = mag * sn;
          const float sh = sinf(0.5f * zi); const float mr = expm1f(zr) * cs - 2.0f * sh * sh, mi = ai;
          const float den = 1.0f / (lr * lr + li * li);
          const float cr = (mr * lr + mi * li) * den, ci = (mi * lr - mr * li) * den;
          const double zr128 = (double)lr * (double)dt * 128.0, zi128 = (double)li * (double)dt * 128.0; const double m128 = exp(zr128);
          f32x4* o = (f32x4*)(tab + (size_t)i * 8); o[0] = (f32x4){ar, ai, cr, ci}; o[1] = (f32x4){(float)(m128 * cos(zi128)), (float)(m128 * sin(zi128)), 0.f, 0.f}; }
      if (gt < 8) ((float*)(ws + WS_MOE + MO_RETLG))[gt] = (float)log2(1.0 - exp2(-5.0 - (double)gt)); }
    { float* ct = (float*)(ws + WS_ROPE); float* st = ct + SEQ * 32;
      const int gt = blockIdx.x * (NWAVES * 64) + tid, GT = gridDim.x * NWAVES * 64;
      for (int i = gt; i < SEQ * 32; i += GT) { const int pos = i >> 5, f = i & 31; const double inv = exp(-(double)f * (9.210340371976184 / 32.0)); const double ang = (double)pos * inv;
          ct[i] = (float)cos(ang); st[i] = (float)sin(ang); } }
}

template <int MODE>
__device__ __forceinline__ void ln_phase(ArgsP a, const float* lnw, const float* lnb, const float* wrouter, LAS unsigned char* lds, int tid, int lane, int wave) {
    unsigned char* ws = a->ws;
    float* out = a->out; bf16* xb = (bf16*)(ws + WS_R2);
    f32x4 wv[4], bv[4];
#pragma unroll
    for (int j = 0; j < 4; ++j) { wv[j] = ((const f32x4*)lnw)[lane + 64 * j]; bv[j] = ((const f32x4*)lnb)[lane + 64 * j]; }
    LAS float* wrs = (LAS float*)lds; LAS int* cnt = (LAS int*)(lds + 32768);
    if (MODE == 1) {
        for (int i = tid; i < 8192; i += NWAVES * 64) { const int c = i >> 3, e = i & 7; wrs[e * 1024 + c] = wrouter[i]; }
        if (tid < 8) cnt[tid] = 0;
        __syncthreads();
    }
    unsigned* selE = (unsigned*)(ws + WS_MOE + MO_SELE); unsigned* selR = (unsigned*)(ws + WS_MOE + MO_SELR); f32x2* selW = (f32x2*)(ws + WS_MOE + MO_SELW);
    const u32x2* tokpos = (const u32x2*)(ws + WS_MOE + MO_TOKPOS); int* counts = (int*)(ws + WS_MOE + MO_COUNTS);
    const bf16* ymoe = (const bf16*)(ws + WS_R1);
    for (int rb = blockIdx.x; rb < NUC; rb += gridDim.x) {
        const int m0 = rb * 128 + wave * 16;
        u32x2 tpl = {0u, 0u}; if (MODE == 2) tpl = tokpos[m0 + (lane & 15)];
        f32x4 nv[4]; u32x2 ny0[4], ny1[4];
        { const f32x4* xr0 = (const f32x4*)(out + (size_t)m0 * D) + lane;
#pragma unroll
          for (int j = 0; j < 4; ++j) nv[j] = xr0[64 * j];
          if (MODE == 2) { const unsigned p0 = __shfl(tpl.x, 0), p1 = __shfl(tpl.y, 0); const u32x2* y0 = (const u32x2*)(ymoe + (size_t)p0 * D) + lane; const u32x2* y1 = (const u32x2*)(ymoe + (size_t)p1 * D) + lane;
#pragma unroll
              for (int j = 0; j < 4; ++j) { ny0[j] = y0[64 * j]; ny1[j] = y1[64 * j]; } } }
        for (int rr = 0; rr < 16; ++rr) {
            const int m = m0 + rr;
            f32x4* xr = (f32x4*)(out + (size_t)m * D) + lane;
            f32x4 v[4]; float s = 0.f;
#pragma unroll
            for (int j = 0; j < 4; ++j) v[j] = nv[j];
            if (MODE == 2) {
#pragma unroll
                for (int j = 0; j < 4; ++j) { const u32x2 p0 = ny0[j], p1 = ny1[j];
                    v[j][0] = ALPHA * v[j][0] + __uint_as_float(p0.x << 16) + __uint_as_float(p1.x << 16);
                    v[j][1] = ALPHA * v[j][1] + __uint_as_float(p0.x & 0xffff0000u) + __uint_as_float(p1.x & 0xffff0000u);
                    v[j][2] = ALPHA * v[j][2] + __uint_as_float(p0.y << 16) + __uint_as_float(p1.y << 16);
                    v[j][3] = ALPHA * v[j][3] + __uint_as_float(p0.y & 0xffff0000u) + __uint_as_float(p1.y & 0xffff0000u); }
            }
            if (rr < 15) {
                const f32x4* xn = (const f32x4*)(out + (size_t)(m + 1) * D) + lane;
#pragma unroll
                for (int j = 0; j < 4; ++j) nv[j] = xn[64 * j];
                if (MODE == 2) { const unsigned p0 = __shfl(tpl.x, rr + 1), p1 = __shfl(tpl.y, rr + 1); const u32x2* y0 = (const u32x2*)(ymoe + (size_t)p0 * D) + lane; const u32x2* y1 = (const u32x2*)(ymoe + (size_t)p1 * D) + lane;
#pragma unroll
                    for (int j = 0; j < 4; ++j) { ny0[j] = y0[64 * j]; ny1[j] = y1[64 * j]; } }
            }
#pragma unroll
            for (int j = 0; j < 4; ++j) s += (v[j][0] + v[j][1]) + (v[j][2] + v[j][3]);
            const float mean = wave_sum(s) * (1.f / D); float s2 = 0.f;
#pragma unroll
            for (int j = 0; j < 4; ++j) { v[j] = v[j] - mean; s2 += (v[j][0] * v[j][0] + v[j][1] * v[j][1]) + (v[j][2] * v[j][2] + v[j][3] * v[j][3]); }
            const float rstd = __builtin_amdgcn_rsqf(wave_sum(s2) * (1.f / D) + LN_EPS);
            u32x2* o8 = (u32x2*)(xb + (size_t)m * D) + lane;
#pragma unroll
            for (int j = 0; j < 4; ++j) { v[j] = v[j] * rstd * wv[j] + bv[j]; xr[64 * j] = v[j]; u32x2 w; w.x = cvtpk(v[j][0], v[j][1]); w.y = cvtpk(v[j][2], v[j][3]); o8[64 * j] = w; }
            if (MODE == 1) {
                float lg[8];
#pragma unroll
                for (int e = 0; e < 8; ++e) { float p = 0.f;
#pragma unroll
                    for (int j = 0; j < 4; ++j) { const f32x4 w4 = *(const LAS f32x4*)(wrs + e * 1024 + 4 * lane + 256 * j); p += (v[j][0] * w4[0] + v[j][1] * w4[1]) + (v[j][2] * w4[2] + v[j][3] * w4[3]); }
                    lg[e] = wave_sum(p); }
                float best = lg[0]; int e0 = 0;
#pragma unroll
                for (int e = 1; e < 8; ++e) if (lg[e] > best) { best = lg[e]; e0 = e; }
                float sec = -3.0e38f; int e1 = 0;
#pragma unroll
                for (int e = 0; e < 8; ++e) if (e != e0 && lg[e] > sec) { sec = lg[e]; e1 = e; }
                if (lane == 0) {
                    const float w0 = __builtin_amdgcn_rcpf(1.0f + __expf(sec - best));
                    const int lr0 = atomicAdd((int*)&cnt[e0], 1), lr1 = atomicAdd((int*)&cnt[e1], 1);
                    selE[m] = (unsigned)e0 | ((unsigned)e1 << 8); selR[m] = (unsigned)lr0 | ((unsigned)lr1 << 16); selW[m] = (f32x2){w0, 1.0f - w0};
                }
            }
        }
        if (MODE == 1) {
            __syncthreads();
            if (tid < 8) { counts[rb * 8 + tid] = cnt[tid]; cnt[tid] = 0; }
            __syncthreads();
        }
    }
}

__device__ __forceinline__ void moe_gather_phase(ArgsP a, LAS unsigned char* lds, int tid, int lane, int wave) {
    unsigned char* ws = a->ws;
    const unsigned* selE = (const unsigned*)(ws + WS_MOE + MO_SELE); const unsigned* selR = (const unsigned*)(ws + WS_MOE + MO_SELR); const f32x2* selW = (const f32x2*)(ws + WS_MOE + MO_SELW);
    u32x2* tokpos = (u32x2*)(ws + WS_MOE + MO_TOKPOS); float* roww = (float*)(ws + WS_MOE + MO_ROWW); const int* counts = (const int*)(ws + WS_MOE + MO_COUNTS); int* panel_exp = (int*)(ws + WS_MOE + MO_PANEL);
    const bf16* xb = (const bf16*)(ws + WS_R2); bf16* Ag = (bf16*)(ws + WS_R1);
    LAS int* sTot = (LAS int*)lds; LAS int* sPre = sTot + 8; LAS int* sBase = sTot + 16; LAS int* sEb = sTot + 24; LAS int* sPad = sTot + 32;
    for (int rb = blockIdx.x; rb < NUC; rb += gridDim.x) {
        { int tot = 0, pre = 0;
          for (int k = lane; k < NUC; k += 64) { const int cv = counts[k * 8 + wave]; tot += cv; if (k < rb) pre += cv; }
          tot = wave_sum_i(tot); pre = wave_sum_i(pre);
          if (lane == 0) { sTot[wave] = tot; sPre[wave] = pre; } }
        __syncthreads();
        if (tid == 0) { int eb = 0;
            for (int e = 0; e < 8; ++e) { const int pad = ((sTot[e] + 255) >> 8) << 8; sEb[e] = eb; sBase[e] = eb + sPre[e]; sPad[e] = pad; eb += pad; }
            if (rb == 0) { int p = 0; for (int e = 0; e < 8; ++e) for (int k = 0; k < (sPad[e] >> 8); ++k) panel_exp[p++] = e;
                __hip_atomic_store((unsigned*)ws + CW_NP, (unsigned)p, RLX_AGENT); } }
        __syncthreads();
        { const int m0 = rb * 128 + wave * 16;
          const unsigned sel = selE[m0 + (lane & 15)], srl = selR[m0 + (lane & 15)]; const f32x2 wl = selW[m0 + (lane & 15)];
          const unsigned p0l = sBase[sel & 255] + (srl & 0xffffu), p1l = sBase[(sel >> 8) & 255] + (srl >> 16);
          if (lane < 16) { roww[p0l] = wl.x; roww[p1l] = wl.y; tokpos[m0 + lane] = (u32x2){p0l, p1l}; }
          const u32x4* src0 = (const u32x4*)(xb + (size_t)m0 * D); u32x4 n0 = src0[lane], n1 = src0[lane + 64];
          for (int rr = 0; rr < 16; ++rr) {
              const u32x4 c0 = n0, c1 = n1;
              if (rr < 15) { const u32x4* src = (const u32x4*)(xb + (size_t)(m0 + rr + 1) * D); n0 = src[lane]; n1 = src[lane + 64]; }
              const unsigned pos0 = __shfl(p0l, rr), pos1 = __shfl(p1l, rr);
              u32x4* d0 = (u32x4*)(Ag + (size_t)pos0 * D); u32x4* d1 = (u32x4*)(Ag + (size_t)pos1 * D);
              d0[lane] = c0; d0[lane + 64] = c1; d1[lane] = c0; d1[lane + 64] = c1;
          } }
        if (rb < 8) { const int e = rb, n0 = sEb[e] + sTot[e], n1 = sEb[e] + sPad[e];
            for (int r = n0 + wave; r < n1; r += NWAVES) { u32x4* d = (u32x4*)(Ag + (size_t)r * D); d[lane] = (u32x4){0u, 0u, 0u, 0u}; d[lane + 64] = (u32x4){0u, 0u, 0u, 0u}; if (lane == 0) roww[r] = 0.f; } }
        __syncthreads();
    }
}

template <bool APPLY>
__device__ __forceinline__ void s5_unit(ArgsP a, int l, int uc, LAS unsigned char* lds, int tid, int lane, int wave) {
    unsigned char* ws = a->ws;
    const bf16* proj = (const bf16*)(ws + WS_R1);
    const int R0 = uc * CH;
    LAS unsigned char* UT = lds;
    LAS unsigned char* XS = lds + 65536 + wave * 8704;
#pragma unroll
    for (int i = 0; i < 8; ++i) { const int idx = tid + 512 * i, r = idx >> 5, ch = idx & 31;
        *(LAS u32x4*)(UT + r * 512 + ch * 16) = *(const u32x4*)(proj + (size_t)(R0 + r) * NPROJ + PC_U + ch * 8); }
    __syncthreads();
    const int cl = lane & 31, hh = lane >> 5, g0 = 2 * wave, lg0 = l * 16 + g0;
    const float* tab = (const float*)(ws + WS_MOE + MO_S5TAB);
    bf16x8 bb[2][4];
#pragma unroll
    for (int gi = 0; gi < 2; ++gi)
#pragma unroll
        for (int pc = 0; pc < 2; ++pc) { const int gp = (lg0 + gi) * 64 + 32 * pc + cl;
            const f32x4 t4 = *(const f32x4*)(tab + (size_t)gp * 8); const float cr = t4[2], ci = t4[3];
            const f32x4 r0 = *(const f32x4*)(a->in[I_BRE] + (size_t)gp * 16 + 8 * hh), r1 = *(const f32x4*)(a->in[I_BRE] + (size_t)gp * 16 + 8 * hh + 4);
            const f32x4 i0 = *(const f32x4*)(a->in[I_BIM] + (size_t)gp * 16 + 8 * hh), i1 = *(const f32x4*)(a->in[I_BIM] + (size_t)gp * 16 + 8 * hh + 4);
            float re[8], im[8];
#pragma unroll
            for (int j = 0; j < 4; ++j) { re[j] = cr * r0[j] - ci * i0[j]; im[j] = cr * i0[j] + ci * r0[j]; re[4 + j] = cr * r1[j] - ci * i1[j]; im[4 + j] = cr * i1[j] + ci * r1[j]; }
            bb[gi][pc] = pack8(re); bb[gi][2 + pc] = pack8(im); }
    float ar[2], ai[2], xr[2], xi[2];
#pragma unroll
    for (int pc = 0; pc < 2; ++pc) { const int gp = (lg0 + hh) * 64 + 32 * pc + cl; const f32x2 t2 = *(const f32x2*)(tab + (size_t)gp * 8); ar[pc] = t2.x; ai[pc] = t2.y; xr[pc] = 0.f; xi[pc] = 0.f;
        if (APPLY) { const f32x2 c0 = ((const f32x2*)(ws + WS_S5CAR))[(size_t)(uc * 16 + g0 + hh) * 64 + 32 * pc + cl]; xr[pc] = c0.x; xi[pc] = c0.y; } }
    bf16x8 cb[2][4]; float dsk[2] = {0.f, 0.f};
    if (APPLY) { const int h = lane & 15;
#pragma unroll
        for (int gi = 0; gi < 2; ++gi) {
#pragma unroll
            for (int s = 0; s < 4; ++s) { const int pp = 4 * (lane >> 4) + 16 * s;
                const f32x4 re = *(const f32x4*)(a->in[I_CRE] + (size_t)((lg0 + gi) * 16 + h) * 64 + pp), im = *(const f32x4*)(a->in[I_CIM] + (size_t)((lg0 + gi) * 16 + h) * 64 + pp);
                float tmp[8] = {re[0], -im[0], re[1], -im[1], re[2], -im[2], re[3], -im[3]}; cb[gi][s] = pack8(tmp); }
            dsk[gi] = a->in[I_SSMD][l * 256 + (g0 + gi) * 16 + h]; } }
    const int tr = tau(cl), gh = tr >> 4, ti = tr & 15;
    const LAS unsigned char* ua = UT + ti * 512 + ((g0 + gh) * 16 + 8 * hh) * 2;
    for (int tb = 0; tb < 8; ++tb) {
        const u32x4 uraw = *(const LAS u32x4*)(ua + tb * 16 * 512);
        const u32x4 z4 = {0u, 0u, 0u, 0u};
        const bf16x8 a0 = __builtin_bit_cast(bf16x8, gh == 0 ? uraw : z4), a1 = __builtin_bit_cast(bf16x8, gh == 1 ? uraw : z4);
        f32x16 bu[4];
#pragma unroll
        for (int c = 0; c < 4; ++c) {
#pragma unroll
            for (int k = 0; k < 16; ++k) bu[c][k] = 0.f;
            bu[c] = MFMA32(a0, bb[0][c], bu[c]); bu[c] = MFMA32(a1, bb[1][c], bu[c]); }
#pragma unroll
        for (int i = 0; i < 16; ++i) {
#pragma unroll
            for (int pc = 0; pc < 2; ++pc) { const float nr = ar[pc] * xr[pc] - ai[pc] * xi[pc] + bu[pc][i], ni = ar[pc] * xi[pc] + ai[pc] * xr[pc] + bu[2 + pc][i]; xr[pc] = nr; xi[pc] = ni;
                if (APPLY) *(LAS unsigned*)(XS + hh * 4352 + i * 272 + (32 * pc + cl) * 4) = cvtpk(nr, ni); }
        }
        if (APPLY) {
            LDS_WAIT();
            const int h = lane & 15;
#pragma unroll
            for (int gi = 0; gi < 2; ++gi) {
                f32x4 y = {0.f, 0.f, 0.f, 0.f};
#pragma unroll
                for (int s = 0; s < 4; ++s) { const bf16x8 xa = *(const LAS bf16x8*)(XS + gi * 4352 + (lane & 15) * 272 + ((lane >> 4) * 8 + 32 * s) * 2); y = MFMA16(xa, cb[gi][s], y); }
#pragma unroll
                for (int r = 0; r < 4; ++r) { const int t = tb * 16 + 4 * (lane >> 4) + r; LAS unsigned short* up = (LAS unsigned short*)(UT + t * 512 + ((g0 + gi) * 16 + h) * 2);
                    const float yy = y[r] + dsk[gi] * bf2f(*up); *up = (unsigned short)(cvtpk(gelu_tanh(yy), 0.f) & 0xffffu); }
            }
            LDS_WAIT();
        }
    }
    if (!APPLY) {
#pragma unroll
        for (int pc = 0; pc < 2; ++pc) ((f32x2*)(ws + WS_S5LOC))[(size_t)(uc * 16 + g0 + hh) * 64 + 32 * pc + cl] = (f32x2){xr[pc], xi[pc]};
    }
    if (APPLY) {
        __syncthreads();
        bf16* gbuf = (bf16*)(ws + WS_GBUF);
#pragma unroll
        for (int i = 0; i < 8; ++i) { const int idx = tid + 512 * i, r = idx >> 5, ch = idx & 31;
            *(u32x4*)(gbuf + (size_t)(R0 + r) * 256 + ch * 8) = *(const LAS u32x4*)(UT + r * 512 + ch * 16); }
    }
    __syncthreads();
}

__device__ __forceinline__ void load_rope(const bf16* rowp, const float* cosr, const float* sinr, int hh, float scale, bf16x8 (&o)[4]) {
    u32x4 raw[4];
#pragma unroll
    for (int s = 0; s < 4; ++s) raw[s] = *(const u32x4*)(rowp + 16 * s + 8 * hh);
#pragma unroll
    for (int s = 0; s < 2; ++s) {
        float x1[8], x2[8], c[8], sn[8], y1[8], y2[8]; unpack8(raw[s], x1); unpack8(raw[s + 2], x2);
        const f32x4 c0 = *(const f32x4*)(cosr + 16 * s + 8 * hh), c1 = *(const f32x4*)(cosr + 16 * s + 8 * hh + 4), s0 = *(const f32x4*)(sinr + 16 * s + 8 * hh), s1 = *(const f32x4*)(sinr + 16 * s + 8 * hh + 4);
#pragma unroll
        for (int j = 0; j < 4; ++j) { c[j] = c0[j]; c[4 + j] = c1[j]; sn[j] = s0[j]; sn[4 + j] = s1[j]; }
#pragma unroll
        for (int j = 0; j < 8; ++j) { y1[j] = (x1[j] * c[j] - x2[j] * sn[j]) * scale; y2[j] = (x1[j] * sn[j] + x2[j] * c[j]) * scale; }
        o[s] = pack8(y1); o[s + 2] = pack8(y2);
    }
}

__device__ __forceinline__ void ret_local_unit(ArgsP a, int uc, int lane, int h) {
    unsigned char* ws = a->ws;
    const bf16* proj = (const bf16*)(ws + WS_R1); const bf16* vT = (const bf16*)(ws + WS_VT);
    const float* cost = (const float*)(ws + WS_ROPE); const float* sint = cost + SEQ * 32;
    const int R0 = uc * CH, s0 = (uc & 127) * CH, cl = lane & 31, hh = lane >> 5;
    const float lg2 = ((const float*)(ws + WS_MOE + MO_RETLG))[h];
    f32x16 kv[2][2];
#pragma unroll
    for (int i = 0; i < 2; ++i)
#pragma unroll
        for (int j = 0; j < 2; ++j)
#pragma unroll
            for (int k = 0; k < 16; ++k) kv[i][j][k] = 0.f;
    bf16x8 idm[2];
#pragma unroll
    for (int s2 = 0; s2 < 2; ++s2) { float t8[8];
#pragma unroll
        for (int j = 0; j < 8; ++j) t8[j] = (16 * s2 + 8 * hh + j == cl) ? 1.0f : 0.0f;
        idm[s2] = pack8(t8); }
#pragma unroll
    for (int ti = 0; ti < 4; ++ti) {
        const int tl = 32 * ti + tau(cl);
        bf16x8 ka[4]; load_rope(proj + (size_t)(R0 + tl) * NPROJ + PC_RK + h * 64, cost + (size_t)(s0 + tl) * 32, sint + (size_t)(s0 + tl) * 32, hh, 0.125f, ka);
        bf16x8 xb[2][2];
#pragma unroll
        for (int dt = 0; dt < 2; ++dt) { f32x16 x;
#pragma unroll
            for (int k = 0; k < 16; ++k) x[k] = 0.f;
            x = MFMA32(ka[2 * dt], idm[0], x); x = MFMA32(ka[2 * dt + 1], idm[1], x);
            float xs[16];
#pragma unroll
            for (int i = 0; i < 16; ++i) xs[i] = x[i] * __builtin_amdgcn_exp2f((float)(127 - (32 * ti + 16 * hh + i)) * lg2);
            xb[dt][0] = pack8(xs); xb[dt][1] = pack8(xs + 8); }
#pragma unroll
        for (int et = 0; et < 2; ++et)
#pragma unroll
            for (int s = 0; s < 2; ++s) { const bf16x8 va = ld8(vT + (size_t)(VT_RV + h * 64 + 32 * et + cl) * T + R0 + 32 * ti + 16 * hh + 8 * s);
                kv[et][0] = MFMA32(va, xb[0][s], kv[et][0]); kv[et][1] = MFMA32(va, xb[1][s], kv[et][1]); }
    }
    float* retloc = (float*)(ws + WS_RETLOC) + (size_t)(uc * 8 + h) * 4096;
#pragma unroll
    for (int et = 0; et < 2; ++et)
#pragma unroll
        for (int dt = 0; dt < 2; ++dt)
#pragma unroll
            for (int i = 0; i < 16; ++i) { const int e = 32 * et + 8 * (i >> 2) + 4 * hh + (i & 3); retloc[e * 64 + 32 * dt + cl] = kv[et][dt][i]; }
}

__device__ __forceinline__ void ret_apply_unit(ArgsP a, int l, int uc, int lane, int h) {
    unsigned char* ws = a->ws;
    const bf16* proj = (const bf16*)(ws + WS_R1); const bf16* vT = (const bf16*)(ws + WS_VT); bf16* ymix = (bf16*)(ws + WS_R3);
    const bf16* prevT = (const bf16*)(ws + WS_RETPREV) + (size_t)(uc * 8 + h) * 4096;
    const float* cost = (const float*)(ws + WS_ROPE); const float* sint = cost + SEQ * 32;
    const float* gw = a->in[I_RETGW] + l * 512 + h * 64; const float* gb = a->in[I_RETGB] + l * 512 + h * 64;
    const int R0 = uc * CH, s0 = (uc & 127) * CH, cl = lane & 31, hh = lane >> 5;
    const float lg2 = ((const float*)(ws + WS_MOE + MO_RETLG))[h];
    bf16x8 kall[4][4];
#pragma unroll
    for (int qi = 0; qi < 4; ++qi) {
        const int ql = 32 * qi + cl;
        { const int kl = 32 * qi + tau(cl);
          load_rope(proj + (size_t)(R0 + kl) * NPROJ + PC_RK + h * 64, cost + (size_t)(s0 + kl) * 32, sint + (size_t)(s0 + kl) * 32, hh, 0.125f, kall[qi]);
 }
        bf16x8 qb[4]; load_rope(proj + (size_t)(R0 + ql) * NPROJ + PC_RQ + h * 64, cost + (size_t)(s0 + ql) * 32, sint + (size_t)(s0 + ql) * 32, hh, 1.0f, qb);
        f32x16 o[2];
        { const float gq1 = __builtin_amdgcn_exp2f((float)(ql + 1) * lg2);
#pragma unroll
          for (int et = 0; et < 2; ++et) { f32x16 ct;
#pragma unroll
              for (int k = 0; k < 16; ++k) ct[k] = 0.f;
#pragma unroll
              for (int s = 0; s < 4; ++s) { const bf16x8 pa = ld8(prevT + (32 * et + cl) * 64 + 16 * s + 8 * hh); ct = MFMA32(pa, qb[s], ct); }
#pragma unroll
              for (int k = 0; k < 16; ++k) o[et][k] = ct[k] * gq1; } }
#pragma unroll
        for (int ki = 0; ki < 4; ++ki) if (ki <= qi) {
            f32x16 st;
#pragma unroll
            for (int k = 0; k < 16; ++k) st[k] = 0.f;
#pragma unroll
            for (int s = 0; s < 4; ++s) st = MFMA32(kall[ki][s], qb[s], st);
            float pv[16];
#pragma unroll
            for (int i = 0; i < 16; ++i) { const int dl = ql - (32 * ki + 16 * hh + i); pv[i] = dl >= 0 ? st[i] * __builtin_amdgcn_exp2f((float)dl * lg2) : 0.f; }
            const bf16x8 pb0 = pack8(pv), pb1 = pack8(pv + 8);
#pragma unroll
            for (int et = 0; et < 2; ++et) { const bf16* vp = vT + (size_t)(VT_RV + h * 64 + 32 * et + cl) * T + R0 + 32 * ki + 16 * hh; o[et] = MFMA32(ld8(vp), pb0, o[et]); o[et] = MFMA32(ld8(vp + 8), pb1, o[et]); }
        }
        float sm = 0.f;
#pragma unroll
        for (int et = 0; et < 2; ++et)
#pragma unroll
            for (int i = 0; i < 16; ++i) sm += o[et][i];
        sm += __shfl_xor(sm, 32);
        const float mean = sm * (1.0f / 64.0f); float sq = 0.f;
#pragma unroll
        for (int et = 0; et < 2; ++et)
#pragma unroll
            for (int i = 0; i < 16; ++i) { const float d = o[et][i] - mean; sq += d * d; }
        sq += __shfl_xor(sq, 32);
        const float rstd = __builtin_amdgcn_rsqf(sq * (1.0f / 64.0f) + LN_EPS);
        const bf16* gp = proj + (size_t)(R0 + ql) * NPROJ + PC_RG + h * 64; bf16* yp = ymix + (size_t)(R0 + ql) * D + 256 + h * 64;
#pragma unroll
        for (int et = 0; et < 2; ++et)
#pragma unroll
            for (int q4 = 0; q4 < 4; ++q4) { const int e0 = 32 * et + 8 * q4 + 4 * hh;
                const f32x4 w4 = *(const f32x4*)(gw + e0), b4 = *(const f32x4*)(gb + e0); const u32x2 gr = *(const u32x2*)(gp + e0);
                const float g0 = __uint_as_float(gr.x << 16), g1 = __uint_as_float(gr.x & 0xffff0000u), g2 = __uint_as_float(gr.y << 16), g3 = __uint_as_float(gr.y & 0xffff0000u);
                const float v0 = ((o[et][4 * q4 + 0] - mean) * rstd * w4[0] + b4[0]) * pg8::fast_silu(g0), v1 = ((o[et][4 * q4 + 1] - mean) * rstd * w4[1] + b4[1]) * pg8::fast_silu(g1);
                const float v2 = ((o[et][4 * q4 + 2] - mean) * rstd * w4[2] + b4[2]) * pg8::fast_silu(g2), v3 = ((o[et][4 * q4 + 3] - mean) * rstd * w4[3] + b4[3]) * pg8::fast_silu(g3);
                u32x2 w; w.x = cvtpk(v0, v1); w.y = cvtpk(v2, v3); *(u32x2*)(yp + e0) = w; }
    }
}

__device__ __forceinline__ void sb_unit(ArgsP a, int l, int uc, int qi, int hd, int lane) {
    unsigned char* ws = a->ws;
    const bf16* proj = (const bf16*)(ws + WS_R1); const bf16* vT = (const bf16*)(ws + WS_VT); bf16* ymix = (bf16*)(ws + WS_R3);
    const int R0 = uc * CH, b = uc >> 7, s0 = (uc & 127) * CH, cl = lane & 31, hh = lane >> 5;
    const int qrow = R0 + 32 * qi + cl, qpos = s0 + 32 * qi + cl;
    bf16x8 qb[4];
#pragma unroll
    for (int s = 0; s < 4; ++s) qb[s] = ld8(proj + (size_t)qrow * NPROJ + PC_SQ + hd * 64 + 16 * s + 8 * hh);
    f32x16 o[2];
#pragma unroll
    for (int et = 0; et < 2; ++et)
#pragma unroll
        for (int k = 0; k < 16; ++k) o[et][k] = 0.f;
    float R = 0.f;
    int kt = (s0 >> 5) + qi;
    const bf16* kp0 = proj + (size_t)(b * SEQ + tau(cl)) * NPROJ + PC_SK + hd * 64 + 8 * hh;
    const bf16* vp0 = vT + (size_t)(VT_SV + hd * 64 + cl) * T + b * SEQ + 16 * hh;
    bf16x8 kc[4], vc[4];
#pragma unroll
    for (int s = 0; s < 4; ++s) kc[s] = ld8(kp0 + (size_t)(32 * kt) * NPROJ + 16 * s);
#pragma unroll
    for (int et = 0; et < 2; ++et) { vc[2 * et] = ld8(vp0 + (size_t)(32 * et) * T + 32 * kt); vc[2 * et + 1] = ld8(vp0 + (size_t)(32 * et) * T + 32 * kt + 8); }
    for (;;) {
        const int ktn = kt > 0 ? kt - 1 : 0;
        bf16x8 kn[4], vn[4];
#pragma unroll
        for (int s = 0; s < 4; ++s) kn[s] = ld8(kp0 + (size_t)(32 * ktn) * NPROJ + 16 * s);
#pragma unroll
        for (int et = 0; et < 2; ++et) { vn[2 * et] = ld8(vp0 + (size_t)(32 * et) * T + 32 * ktn); vn[2 * et + 1] = ld8(vp0 + (size_t)(32 * et) * T + 32 * ktn + 8); }
        f32x16 st;
#pragma unroll
        for (int k = 0; k < 16; ++k) st[k] = 0.f;
#pragma unroll
        for (int s = 0; s < 4; ++s) st = MFMA32(kc[s], qb[s], st);
        float lb[16], aft[16]; float run = 0.f;
#pragma unroll
        for (int i = 15; i >= 0; --i) { const float z = st[i] * 0.125f; const bool valid = (32 * kt + 16 * hh + i) < qpos;
            const float sp = fmaxf(z, 0.f) + __logf(1.0f + __expf(-fabsf(z)));
            lb[i] = valid ? (z - sp) : -1.0e30f;
            aft[i] = run; run += valid ? -sp : 0.f; }
        const float oth = __shfl_xor(run, 32);
        const float off = R + (hh == 0 ? oth : 0.f);
        float pv[16];
#pragma unroll
        for (int i = 0; i < 16; ++i) pv[i] = __expf(lb[i] + aft[i] + off);
        R += run + oth;
        const bf16x8 pb0 = pack8(pv), pb1 = pack8(pv + 8);
#pragma unroll
        for (int et = 0; et < 2; ++et) { o[et] = MFMA32(vc[2 * et], pb0, o[et]); o[et] = MFMA32(vc[2 * et + 1], pb1, o[et]); }
        if (kt == 0 || __all(R < -SB_THR)) break;
        kt = ktn;
#pragma unroll
        for (int s = 0; s < 4; ++s) { kc[s] = kn[s]; vc[s] = vn[s]; }
    }
    float ss = 0.f;
#pragma unroll
    for (int et = 0; et < 2; ++et)
#pragma unroll
        for (int i = 0; i < 16; ++i) ss += o[et][i] * o[et][i];
    ss += __shfl_xor(ss, 32);
    const float r = __builtin_amdgcn_rsqf(ss * (1.0f / 64.0f) + LN_EPS);
    const float* nw = a->in[I_SBNW] + l * 256 + hd * 64; bf16* yp = ymix + (size_t)qrow * D + 768 + hd * 64;
#pragma unroll
    for (int et = 0; et < 2; ++et)
#pragma unroll
        for (int q4 = 0; q4 < 4; ++q4) { const int e0 = 32 * et + 8 * q4 + 4 * hh; const f32x4 w4 = *(const f32x4*)(nw + e0);
            u32x2 w; w.x = cvtpk(o[et][4 * q4 + 0] * r * w4[0], o[et][4 * q4 + 1] * r * w4[1]); w.y = cvtpk(o[et][4 * q4 + 2] * r * w4[2], o[et][4 * q4 + 3] * r * w4[3]); *(u32x2*)(yp + e0) = w; }
}

__device__ __forceinline__ void carry_phase(ArgsP a, int l, int tid) {
    unsigned char* ws = a->ws;
    const int gt = blockIdx.x * (NWAVES * 64) + tid, GT = gridDim.x * NWAVES * 64;
    for (int idx = gt; idx < BATCH * 8 * 4096; idx += GT) {
        const int b = idx >> 15, h = (idx >> 12) & 7, ed = idx & 4095;
        const float dec = __builtin_amdgcn_exp2f(128.0f * ((const float*)(ws + WS_MOE + MO_RETLG))[h]);
        const float* loc = (const float*)(ws + WS_RETLOC) + (size_t)(b * 128 * 8 + h) * 4096 + ed; bf16* prv = (bf16*)(ws + WS_RETPREV) + (size_t)(b * 128 * 8 + h) * 4096 + ed;
        float S = 0.f;
#pragma unroll 8
        for (int c = 0; c < 128; ++c) { const float v = loc[(size_t)c * 8 * 4096]; prv[(size_t)c * 8 * 4096] = (unsigned short)(cvtpk(S, 0.f) & 0xffffu); S = dec * S + v; }
    }
    for (int idx = GT - 1 - gt; idx < BATCH * 16 * 64; idx += GT) {
        const int b = idx >> 10, g = (idx >> 6) & 15, p = idx & 63, lg = l * 16 + g;
        const f32x4 tb4 = *(const f32x4*)((const float*)(ws + WS_MOE + MO_S5TAB) + (size_t)(lg * 64 + p) * 8 + 4);
        const float ar = tb4[0], ai = tb4[1];
        const f32x2* loc = (const f32x2*)(ws + WS_S5LOC) + (size_t)(b * 128 * 16 + g) * 64 + p; f32x2* car = (f32x2*)(ws + WS_S5CAR) + (size_t)(b * 128 * 16 + g) * 64 + p;
        float xr = 0.f, xi = 0.f;
#pragma unroll 8
        for (int c = 0; c < 128; ++c) { const f32x2 v = loc[(size_t)c * 16 * 64]; car[(size_t)c * 16 * 64] = (f32x2){xr, xi}; const float nr = ar * xr - ai * xi + v.x, ni = ar * xi + ai * xr + v.y; xr = nr; xi = ni; }
    }
}

#define RELAUNDER() do { int t_ = threadIdx.x; asm volatile("" : "+v"(t_)); tid = t_; lane = tid & 63; wave = __builtin_amdgcn_readfirstlane(tid >> 6); int g_ = gridDim.x, b_ = blockIdx.x; asm volatile("" : "+s"(g_), "+s"(b_)); G = g_; bid = b_; \
        ArgsP p_ = (ArgsP)__builtin_amdgcn_kernarg_segment_ptr(); asm volatile("" : "+s"(p_)); ap = p_; ws = ap->ws; } while (0)
#define GRID_BAR() do { xcd_barrier(bar); RELAUNDER(); } while (0)
#define LAUNDER_LANE() do { int t_ = threadIdx.x; asm volatile("" : "+v"(t_)); tid = t_; lane = tid & 63; wave = __builtin_amdgcn_readfirstlane(tid >> 6); } while (0)
#define xb ((bf16*)(ws + WS_R2))
#define proj ((bf16*)(ws + WS_R1))
#define vT ((bf16*)(ws + WS_VT))
#define ymix ((bf16*)(ws + WS_R3))
#define out (ap->out)


template <int l>
__device__ __forceinline__ void layer_body(const XcdBarrier& bar, LAS unsigned char* lds) {
    int tid, lane, wave, G, bid; ArgsP ap; unsigned char* ws;
    RELAUNDER();
        const bf16* win_t = (const bf16*)(ws + WS_WIN) + (size_t)l * 3072 * 1024;
#ifndef NO_G0
        { pg8::Gemm g{xb, win_t, T, NPROJ, D}; pg8::StaticOrder S; S.init(T, NPROJ, G, bid); pg8::EpiStoreBf16 E{proj, NPROJ};
          pg8::gemm_phase<pg8::EpiStoreBf16, pg8::StaticOrder, PG8_ALIGN, PG8_SP2>(lds + RING_OFF, g, S, E); }
#endif
#ifndef NO_G1
        { pg8::Gemm g{win_t + (size_t)NPROJ * D, xb, NVT, T, D}; pg8::StaticOrder S; S.init(NVT, T, G, bid); pg8::EpiStoreBf16 E{vT, T};
          pg8::gemm_phase<pg8::EpiStoreBf16, pg8::StaticOrder, PG8_ALIGN, PG8_SP2>(lds + RING_OFF, g, S, E); }
#endif
        GRID_BAR();
        for (int uc = bid; uc < NUC; uc += G) {
#ifndef NO_S5L
            LAUNDER_LANE();
            s5_unit<false>(ap, l, uc, lds, tid, lane, wave);
#endif
#ifndef NO_RETL
            LAUNDER_LANE();
            ret_local_unit(ap, uc, lane, wave);
#endif
#ifndef NO_SB
            LAUNDER_LANE();
            sb_unit(ap, l, uc, wave >> 2, wave & 3, lane);
            LAUNDER_LANE();
            sb_unit(ap, l, uc, 2 + (wave >> 2), wave & 3, lane);
#endif
        }
        GRID_BAR();
#ifndef NO_CARRY
        carry_phase(ap, l, tid);
#endif
        GRID_BAR();
        for (int uc = bid; uc < NUC; uc += G) {
#ifndef NO_S5A
            LAUNDER_LANE();
            s5_unit<true>(ap, l, uc, lds, tid, lane, wave);
#endif
#ifndef NO_RETA
            LAUNDER_LANE();
            ret_apply_unit(ap, l, uc, lane, wave);
#endif
        }
        GRID_BAR();
#ifndef NO_G2
        { int kglu = 256; asm volatile("" : "+s"(kglu));
          pg8::Gemm g{(const bf16*)(ws + WS_GBUF), (const bf16*)(ws + WS_GLU) + (size_t)l * 65536, T, 256, kglu}; pg8::StaticOrder S; S.init(T, 256, G, bid);
          pg8::EpiGLU E{(const bf16*)(ws + WS_GBUF), ap->in[I_GLUB] + l * 256, ap->in[I_SSMNW] + l * 256, ymix, D, LN_EPS};
          pg8::gemm_phase<pg8::EpiGLU, pg8::StaticOrder, PG8_ALIGN, PG8_SP2>(lds + RING_OFF, g, S, E); }
#endif
        GRID_BAR();
#ifndef NO_G3
        { pg8::Gemm g{ymix, (const bf16*)(ws + WS_WOUT) + (size_t)l * D * D, T, D, D}; pg8::StaticOrder S; S.init(T, D, G, bid);
          pg8::EpiResF32 E{l == 0 ? ap->in[I_X] : out, out, D, ALPHA};
          pg8::gemm_phase<pg8::EpiResF32, pg8::StaticOrder, PG8_ALIGN, PG8_SP2>(lds + RING_OFF, g, S, E); }
#endif
        GRID_BAR();
        const int li = l >> 1;
        if (l & 1) {
#ifndef NO_LN
            ln_phase<1>(ap, ap->in[I_LNMW] + l * D, ap->in[I_LNMB] + l * D, ap->in[I_ROUTER] + (size_t)li * D * NE, lds, tid, lane, wave);
#endif
            GRID_BAR();
#ifndef NO_LN
            moe_gather_phase(ap, lds, tid, lane, wave);
#endif
            GRID_BAR();
            const int np = (int)__builtin_amdgcn_readfirstlane(__hip_atomic_load((unsigned*)ws + CW_NP, RLX_AGENT));
            const int* panel_exp = (const int*)(ws + WS_MOE + MO_PANEL);
#ifndef NO_G4
            { pg8::Gemm g{(const bf16*)(ws + WS_R1), (const bf16*)(ws + WS_MGU) + (size_t)li * NE * 1536 * 1024, np * 256, 1536, D}; pg8::MoeOrder S{panel_exp, 6, np * 6, G, bid};
              pg8::EpiSwiGLU<true> E{(bf16*)(ws + WS_R2), EFFP, (const float*)(ws + WS_MOE + MO_ROWW)};
              pg8::gemm_phase<pg8::EpiSwiGLU<true>, pg8::MoeOrder, PG8_ALIGN, PG8_SP2>(lds + RING_OFF, g, S, E); }
#endif
            GRID_BAR();
#ifndef NO_G5
            { pg8::Gemm g{(const bf16*)(ws + WS_R2), (const bf16*)(ws + WS_MDN) + (size_t)li * NE * 1024 * EFFP, np * 256, D, EFFP}; pg8::MoeOrder S{panel_exp, 4, np * 4, G, bid};
              pg8::EpiStoreBf16 E{(bf16*)(ws + WS_R1), D};
              pg8::gemm_phase<pg8::EpiStoreBf16, pg8::MoeOrder, PG8_ALIGN, PG8_SP2>(lds + RING_OFF, g, S, E); }
#endif
            GRID_BAR();
#ifndef NO_LN
            ln_phase<2>(ap, ap->in[I_LNFW] + l * D, ap->in[I_LNFB] + l * D, nullptr, lds, tid, lane, wave);
#endif
            GRID_BAR();
        } else {
#ifndef NO_LN
            ln_phase<0>(ap, ap->in[I_LNMW] + l * D, ap->in[I_LNMB] + l * D, nullptr, lds, tid, lane, wave);
#endif
            GRID_BAR();
#ifndef NO_G6
            { pg8::Gemm g{xb, (const bf16*)(ws + WS_FGU) + (size_t)li * 5632 * 1024, T, 5632, D}; pg8::StaticOrder S; S.init(T, 5632, G, bid);
              pg8::EpiSwiGLU<false> E{(bf16*)(ws + WS_R1), DFFP, nullptr};
              pg8::gemm_phase<pg8::EpiSwiGLU<false>, pg8::StaticOrder, PG8_ALIGN, PG8_SP2>(lds + RING_OFF, g, S, E); }
#endif
            GRID_BAR();
#ifndef NO_G7
            { pg8::Gemm g{(const bf16*)(ws + WS_R1), (const bf16*)(ws + WS_FDN) + (size_t)li * 1024 * DFFP, T, D, DFFP}; pg8::StaticOrder S; S.init(T, D, G, bid);
              pg8::EpiResF32 E{out, out, D, ALPHA};
              pg8::gemm_phase<pg8::EpiResF32, pg8::StaticOrder, PG8_ALIGN, PG8_SP2>(lds + RING_OFF, g, S, E); }
#endif
            GRID_BAR();
#ifndef NO_LN
            ln_phase<0>(ap, ap->in[I_LNFW] + l * D, ap->in[I_LNFB] + l * D, nullptr, lds, tid, lane, wave);
#endif
            GRID_BAR();
        }
}

__global__ void __launch_bounds__(NWAVES * 64, 2) hybrid_fwd(Args args) {
    extern __shared__ __attribute__((aligned(16))) unsigned char lds_raw[];
    LAS unsigned char* lds = (LAS unsigned char*)lds_raw;
    int tid, lane, wave, G, bid; ArgsP ap; unsigned char* ws;
    RELAUNDER();
    for (int u = tid; u < (LDS_BYTES - LDSCTL_OFF) / 4; u += NWAVES * 64) ((LAS unsigned*)(lds + LDSCTL_OFF))[u] = 0u;
    __syncthreads();
    XcdBarrier bar = xcd_barrier_post((unsigned*)(ws + WS_CTL) + CW_BAR, (volatile LAS unsigned*)(lds + MISC_OFF) + 8);
#ifndef NO_P0
    p0_prologue(ap, lds, tid, lane, wave);
#endif
    GRID_BAR();
    layer_body<0>(bar, lds); layer_body<1>(bar, lds); layer_body<2>(bar, lds); layer_body<3>(bar, lds);
#undef GRID_BAR
#undef RELAUNDER
#undef LAUNDER_LANE
#undef xb
#undef proj
#undef vT
#undef ymix
#undef out
}

extern "C" void kernel_launch(void* const* d_in, const int* in_sizes, int n_in, void* d_out, int out_size, void* d_ws, size_t ws_size, hipStream_t stream) {
    static int grid = 0;
    if (grid == 0) {
        if (n_in != 28 || out_size != T * D || ws_size < WS_END) { fprintf(stderr, "kernel_launch: unexpected problem shape (n_in %d, out %d, ws %zu); nothing launched\n", n_in, out_size, ws_size); grid = -1; return; }
        int dev = 0, cus = 0, per_cu = 0;
        if (hipGetDevice(&dev) != hipSuccess || hipDeviceGetAttribute(&cus, hipDeviceAttributeMultiprocessorCount, dev) != hipSuccess) { grid = -1; return; }
        if (hipFuncSetAttribute((const void*)hybrid_fwd, hipFuncAttributeMaxDynamicSharedMemorySize, LDS_BYTES) != hipSuccess) { fprintf(stderr, "kernel_launch: hipFuncSetAttribute failed\n"); grid = -1; return; }
        if (hipOccupancyMaxActiveBlocksPerMultiprocessor(&per_cu, (const void*)hybrid_fwd, NWAVES * 64, LDS_BYTES) != hipSuccess || per_cu < 1)
            fprintf(stderr, "kernel_launch: note: occupancy query reports %d workgroups per CU\n", per_cu);
        (void)hipGetLastError();
        grid = cus < 256 ? cus : 256;
    }
    if (grid < 0) return;
    if (hipMemsetAsync((char*)d_ws + WS_CTL, 0, CTL_ZERO_BYTES, stream) != hipSuccess) return;
    Args a{};
    for (int i = 0; i < 28; ++i) a.in[i] = (const float*)d_in[i];
    a.out = (float*)d_out; a.ws = (unsigned char*)d_ws;
    hipLaunchKernelGGL(hybrid_fwd, dim3(grid), dim3(NWAVES * 64), LDS_BYTES, stream, a);
}
```

```cpp
#include <hip/hip_runtime.h>
#include <cstdio>
#include <cstdint>
namespace pg8 {
#define PG8_LAS __attribute__((address_space(3)))
typedef unsigned short bf16_t;
typedef short bf16x8 __attribute__((ext_vector_type(8)));
typedef float f32x4 __attribute__((ext_vector_type(4)));
typedef unsigned u32x4 __attribute__((ext_vector_type(4)));
constexpr int BM = 256, BK = 64, HALF = 128, HTB = HALF * BK * 2  , STAGE_BYTES = 8 * HTB, NXCD = 8, WGM = 8;

__host__ __device__ __forceinline__ int lds_byte(int r, int c) { const int st = (r >> 4) * 2 + (c >> 5), rr = r & 15, cc = c & 31, ob = rr * 64 + cc * 2; return st * 1024 + (ob ^ (((ob >> 9) & 1) << 5)); }
__host__ __device__ __forceinline__ void stage_rc(int b, int& R, int& C) { const int st = b / 1024, sb = b % 1024, swz = sb ^ (((sb >> 9) & 1) << 5); R = (st >> 1) * 16 + swz / 64; C = (st & 1) * 32 + (swz % 64) / 2; }
__host__ __device__ __forceinline__ int perm32(int rho) { const int n = rho >> 4, i = rho & 15; return 8 * (i >> 2) + 4 * n + (i & 3); }

struct Unit { int pm, pn, pa, pb, kind; };
struct Gemm { const bf16_t* A; const bf16_t* Bt; int M, N, K; };

struct StaticOrder {
    int nM, nN, nwg, G, c;
    __host__ __device__ void init(int M, int N, int G_, int c_) { nM = M / BM; nN = N / BM; nwg = nM * nN; G = G_; c = c_; }
    __host__ __device__ bool next(int i, Unit& u) const { return map((long)i * G + c, u); }
    __host__ __device__ bool map(long L, Unit& u) const {
        if (L >= nwg) return false;
        int wgid = (int)L; { const int q = nwg / NXCD, r = nwg % NXCD, xcd = wgid % NXCD, off = wgid / NXCD; wgid = (xcd < r ? xcd * (q + 1) : r * (q + 1) + (xcd - r) * q) + off; }
        const int nig = WGM * nN, gid = wgid / nig, fm = gid * WGM, gsz = (nM - fm) < WGM ? (nM - fm) : WGM;
        u.pm = fm + ((wgid % nig) % gsz); u.pn = (wgid % nig) / gsz; u.pa = u.pm; u.pb = u.pn; u.kind = 0; return true;
    }
    __device__ __forceinline__ void a_ready(const Unit&) const {}
    __device__ __forceinline__ void done(const Unit&) const {}
};

__device__ __forceinline__ unsigned cvt_pk_bf16(float lo, float hi) { unsigned r; asm volatile("v_cvt_pk_bf16_f32 %0, %1, %2" : "=v"(r) : "v"(lo), "v"(hi)); return r; }
typedef float f32x2 __attribute__((ext_vector_type(2)));
__device__ __forceinline__ f32x2 gelu_pk(f32x2 v) {
    const f32x2 av = __builtin_elementwise_abs(v), d = av * 0.2316418882f + 1.0f;
    f32x2 t; t.x = __builtin_amdgcn_rcpf(d.x); t.y = __builtin_amdgcn_rcpf(d.y);
    f32x2 q = t * 0.5307027145f + (-0.7265760135f); q = q * t + 0.7107068705f; q = q * t + (-0.142248368f); q = q * t + 0.127414796f; q = q * t;
    const f32x2 s = (v * v) * (-0.72134752044f);
    f32x2 e; e.x = __builtin_amdgcn_exp2f(s.x); e.y = __builtin_amdgcn_exp2f(s.y);
    const f32x2 m = v * (q * e), r = v - m;
    f32x2 o; o.x = v.x < 0.f ? m.x : r.x; o.y = v.y < 0.f ? m.y : r.y; return o;
}

__device__ __forceinline__ float fast_silu(float x) { return x * __builtin_amdgcn_rcpf(1.0f + __expf(-x)); }
__device__ __forceinline__ float bf2f(unsigned short b) { return __uint_as_float(((unsigned)b) << 16); }

struct EpiStoreBf16 {
    static constexpr bool PERM = true, AFTER_DRAIN = false;
    bf16_t* O; int ldc;
    __device__ __forceinline__ void operator()(const f32x4 (&acc)[2][2][4][2], const Unit& u, int wr, int wc, int fr, int fq) const {
        const int row0 = u.pm * BM + wr * 64 + fr, col0 = u.pn * BM + wc * 32 + 8 * fq;
#pragma unroll
        for (int ai = 0; ai < 2; ++ai)
#pragma unroll
            for (int m = 0; m < 4; ++m) { bf16_t* rowp = O + (size_t)(row0 + ai * HALF + m * 16) * ldc + col0;
#pragma unroll
                for (int bj = 0; bj < 2; ++bj) { const f32x4 v0 = acc[ai][bj][m][0], v1 = acc[ai][bj][m][1];
                    u32x4 w; w.x = cvt_pk_bf16(v0[0], v0[1]); w.y = cvt_pk_bf16(v0[2], v0[3]); w.z = cvt_pk_bf16(v1[0], v1[1]); w.w = cvt_pk_bf16(v1[2], v1[3]);
                    *(u32x4*)(rowp + bj * HALF) = w; } }
    }
};
struct EpiResF32 {
    static constexpr bool PERM = false, AFTER_DRAIN = false;
    const float* src; float* dst; int ldc; float alpha;
    __device__ __forceinline__ void operator()(const f32x4 (&acc)[2][2][4][2], const Unit& u, int wr, int wc, int fr, int fq) const {
        const int row0 = u.pm * BM + wr * 64 + fr, col0 = u.pn * BM + wc * 32 + 4 * fq;
#pragma unroll
        for (int ai = 0; ai < 2; ++ai)
#pragma unroll
            for (int m = 0; m < 4; ++m) { const size_t ro = (size_t)(row0 + ai * HALF + m * 16) * ldc + col0;
#pragma unroll
                for (int bj = 0; bj < 2; ++bj)
#pragma unroll
                    for (int n = 0; n < 2; ++n) { const f32x4 s = *(const f32x4*)(src + ro + bj * HALF + n * 16); *(f32x4*)(dst + ro + bj * HALF + n * 16) = s * alpha + acc[ai][bj][m][n]; } }
    }
};
template <bool ROWW> struct EpiSwiGLU {
    static constexpr bool PERM = true, AFTER_DRAIN = false;
    bf16_t* H; int ldh; const float* roww;
    __device__ __forceinline__ void operator()(const f32x4 (&acc)[2][2][4][2], const Unit& u, int wr, int wc, int fr, int fq) const {
        const int row0 = u.pm * BM + wr * 64 + fr, col0 = u.pn * HALF + wc * 32 + 8 * fq;
#pragma unroll
        for (int ai = 0; ai < 2; ++ai)
#pragma unroll
            for (int m = 0; m < 4; ++m) { const int row = row0 + ai * HALF + m * 16; const float rw = ROWW ? roww[row] : 1.0f;
                float h[8];
#pragma unroll
                for (int n = 0; n < 2; ++n)
#pragma unroll
                    for (int j = 0; j < 4; ++j) h[4 * n + j] = fast_silu(acc[ai][0][m][n][j]) * acc[ai][1][m][n][j] * rw;
                u32x4 w; w.x = cvt_pk_bf16(h[0], h[1]); w.y = cvt_pk_bf16(h[2], h[3]); w.z = cvt_pk_bf16(h[4], h[5]); w.w = cvt_pk_bf16(h[6], h[7]);
                *(u32x4*)(H + (size_t)row * ldh + col0) = w; }
    }
};
struct EpiGLU {
    static constexpr bool PERM = true, AFTER_DRAIN = false;
    const bf16_t* G; const float* glu_b; const float* norm_w; bf16_t* Y; int ldy; float eps;
    __device__ __forceinline__ void operator()(const f32x4 (&acc)[2][2][4][2], const Unit& u, int wr, int wc, int fr, int fq) const {
        const int row0 = u.pm * BM + wr * 64 + fr, col0 = wc * 32 + 8 * fq;
        const bf16_t* G = this->G; const float* glu_b = this->glu_b; const float* norm_w = this->norm_w; bf16_t* Y = this->Y;
        asm volatile("" : "+s"(G), "+s"(glu_b), "+s"(norm_w), "+s"(Y));
#pragma unroll
        for (int bj = 0; bj < 2; ++bj) { const int col = col0 + bj * HALF;
            const f32x4 b0 = *(const f32x4*)(glu_b + col), b1 = *(const f32x4*)(glu_b + col + 4), n0 = *(const f32x4*)(norm_w + col), n1 = *(const f32x4*)(norm_w + col + 4);
#pragma unroll
            for (int ai = 0; ai < 2; ++ai)
#pragma unroll
                for (int m = 0; m < 4; ++m) { const int row = row0 + ai * HALF + m * 16;
                    const u32x4 gr = *(const u32x4*)(G + (size_t)row * 256 + col);
                    float gv[8]; gv[0] = __uint_as_float(gr.x << 16); gv[1] = __uint_as_float(gr.x & 0xffff0000u); gv[2] = __uint_as_float(gr.y << 16); gv[3] = __uint_as_float(gr.y & 0xffff0000u);
                    gv[4] = __uint_as_float(gr.z << 16); gv[5] = __uint_as_float(gr.z & 0xffff0000u); gv[6] = __uint_as_float(gr.w << 16); gv[7] = __uint_as_float(gr.w & 0xffff0000u);
                    float o[8]; float ss = 0.f;
#pragma unroll
                    for (int j = 0; j < 4; ++j) { const float z0 = acc[ai][bj][m][0][j] + b0[j], z1 = acc[ai][bj][m][1][j] + b1[j];
                        o[j] = gv[j] * __builtin_amdgcn_rcpf(1.0f + __expf(-z0)); o[4 + j] = gv[4 + j] * __builtin_amdgcn_rcpf(1.0f + __expf(-z1)); ss += o[j] * o[j] + o[4 + j] * o[4 + j]; }
                    ss += __shfl_xor(ss, 16);
                    const float r = __builtin_amdgcn_rsqf(ss * (1.0f / 16.0f) + eps);
                    u32x4 w; w.x = cvt_pk_bf16(o[0] * r * n0[0], o[1] * r * n0[1]); w.y = cvt_pk_bf16(o[2] * r * n0[2], o[3] * r * n0[3]);
                    w.z = cvt_pk_bf16(o[4] * r * n1[0], o[5] * r * n1[1]); w.w = cvt_pk_bf16(o[6] * r * n1[2], o[7] * r * n1[3]);
                    *(u32x4*)(Y + (size_t)row * ldy + col) = w; asm volatile("" ::: "memory"); } }
    }
};
struct MoeOrder {
    const int* panel_exp; int NT, nunits, G, c;
    __device__ __forceinline__ bool next(int i, Unit& u) const {
        const int L = i * G + c; if (L >= nunits) return false;
        const int p = L / NT, t = L - p * NT; u.pm = p; u.pn = t; u.pa = p; u.pb = __builtin_amdgcn_readfirstlane(panel_exp[p]) * NT + t; u.kind = 0; return true;
    }
    __device__ __forceinline__ void a_ready(const Unit&) const {}
    __device__ __forceinline__ void done(const Unit&) const {}
};

struct ProjOrder {
    StaticOrder s0, s1; int xt0, wt0, G, c;
    __device__ __forceinline__ void init(int G_, int c_, int xt0_, int wt0_) { G = G_; c = c_; xt0 = xt0_; wt0 = wt0_; s0.init(32768, 2304, G_, c_); s1.init(768, 32768, G_, c_); }
    __device__ __forceinline__ bool next(int i, Unit& u) const {
        const long L = (long)i * G + c;
        if (L < 1152) { s0.map(L, u); u.pa = xt0 + u.pm; u.pb = wt0 + u.pn; u.kind = 0; return true; }
        if (L < 1536) { s1.map(L - 1152, u); u.pa = wt0 + 9 + u.pm; u.pb = xt0 + u.pn; u.kind = 1; return true; }
        return false;
    }
    __device__ __forceinline__ void a_ready(const Unit&) const {}
    __device__ __forceinline__ void done(const Unit&) const {}
};
struct EpiProj {
    static constexpr bool PERM = true, AFTER_DRAIN = false;
    bf16_t* O0; int ldc0; bf16_t* O1; int ldc1;
    __device__ __forceinline__ void operator()(const f32x4 (&acc)[2][2][4][2], const Unit& u, int wr, int wc, int fr, int fq) const {
        bf16_t* O = u.kind ? O1 : O0; const int ldc = u.kind ? ldc1 : ldc0;
        const int row0 = u.pm * BM + wr * 64 + fr, col0 = u.pn * BM + wc * 32 + 8 * fq;
#pragma unroll
        for (int ai = 0; ai < 2; ++ai)
#pragma unroll
            for (int m = 0; m < 4; ++m) { bf16_t* rowp = O + (size_t)(row0 + ai * HALF + m * 16) * ldc + col0;
#pragma unroll
                for (int bj = 0; bj < 2; ++bj) { const f32x4 v0 = acc[ai][bj][m][0], v1 = acc[ai][bj][m][1];
                    u32x4 w; w.x = cvt_pk_bf16(v0[0], v0[1]); w.y = cvt_pk_bf16(v0[2], v0[3]); w.z = cvt_pk_bf16(v1[0], v1[1]); w.w = cvt_pk_bf16(v1[2], v1[3]);
                    *(u32x4*)(rowp + bj * HALF) = w; } }
    }
};

template <class Epi, class Sched, bool ALIGN_EPI = false, bool SP2 = false>
__device__ __forceinline__ void gemm_phase(PG8_LAS unsigned char* lds, const Gemm g, const Sched& S, const Epi& E) {
    int tid_o = threadIdx.x; asm volatile("" : "+v"(tid_o));
    const int tid = tid_o, wid = __builtin_amdgcn_readfirstlane(tid >> 6), lane = tid & 63, wr = wid >> 2, wc = wid & 3, fr = lane & 15, fq = lane >> 4;
    const int K = g.K, nt = K / BK;
    unsigned voffA[2], voffB[2];
#pragma unroll
    for (int i = 0; i < 2; ++i) { int R, C; stage_rc(tid * 16 + i * 8192, R, C); const int Rb = Epi::PERM ? ((R & ~31) + perm32(R & 31)) : R;
        voffA[i] = (unsigned)(R * K + C) * 2u; voffB[i] = (unsigned)(Rb * K + C) * 2u; }
    const size_t kstep = (size_t)(BK * 2);
    const size_t hstep = (size_t)HALF * K * 2;
    const size_t tstep = 2 * hstep;
    const unsigned ldsw = (unsigned)wid * 1024u;
    const int aoff = lds_byte(wr * 64 + fr, fq * 8), boff = lds_byte(wc * 32 + fr, fq * 8);
#define PG8_SA(b, h) (((b) * 2 + (h)) * HTB)
#define PG8_SB(b, h) ((4 + (b) * 2 + (h)) * HTB)
#define PG8_STAGE(bufoff, gbase, voff) do { _Pragma("unroll") for (int _i = 0; _i < 2; ++_i) \
        __builtin_amdgcn_global_load_lds((const unsigned*)((const char*)(gbase) + (voff)[_i]), (PG8_LAS unsigned*)(lds + (bufoff) + ldsw + _i * 8192), 16, 0, 0); } while (0)
#define PG8_LDA(dst, b, h) do { _Pragma("unroll") for (int m = 0; m < 4; ++m) _Pragma("unroll") for (int k = 0; k < 2; ++k) dst[m][k] = *(const PG8_LAS bf16x8*)(lds + PG8_SA(b, h) + aoff + m * 2048 + k * 1024); } while (0)
#define PG8_LDB(dst, b, h) do { _Pragma("unroll") for (int n = 0; n < 2; ++n) _Pragma("unroll") for (int k = 0; k < 2; ++k) dst[n][k] = *(const PG8_LAS bf16x8*)(lds + PG8_SB(b, h) + boff + n * 2048 + k * 1024); } while (0)
#define PG8_MMA(ai, bj, At, Bt) do { __builtin_amdgcn_s_setprio(1); _Pragma("unroll") for (int m = 0; m < 4; ++m) _Pragma("unroll") for (int n = 0; n < 2; ++n) _Pragma("unroll") for (int k = 0; k < 2; ++k) \
        acc[ai][bj][m][n] = __builtin_amdgcn_mfma_f32_16x16x32_bf16(Bt[n][k], At[m][k], acc[ai][bj][m][n], 0, 0, 0); __builtin_amdgcn_s_setprio(0); } while (0)
#define PG8_WAIT_V(n) asm volatile("s_waitcnt vmcnt(" #n ")" ::: "memory")
#define PG8_WAIT_L(n) asm volatile("s_waitcnt lgkmcnt(" #n ")" ::: "memory")
#define PG8_BAR __builtin_amdgcn_s_barrier()
#define PG8_SCHED __builtin_amdgcn_sched_barrier(0)
    Unit cur, nxt; int ui = 0;
    if (!S.next(0, cur)) return;
    f32x4 acc[2][2][4][2];
#pragma unroll
    for (int a = 0; a < 2; ++a)
#pragma unroll
        for (int b = 0; b < 2; ++b)
#pragma unroll
            for (int m = 0; m < 4; ++m)
#pragma unroll
                for (int n = 0; n < 2; ++n) acc[a][b][m][n] = (f32x4){0.f, 0.f, 0.f, 0.f};
    bf16x8 At[4][2], B0[2][2], B1[2][2];
    const char* cA = (const char*)g.A + (size_t)cur.pa * tstep; const char* cB = (const char*)g.Bt + (size_t)cur.pb * tstep;
    S.a_ready(cur);
    if constexpr (SP2) {
        PG8_STAGE(PG8_SB(0, 0), cB, voffB); PG8_STAGE(PG8_SB(0, 1), cB + hstep, voffB); PG8_STAGE(PG8_SA(0, 0), cA, voffA); PG8_STAGE(PG8_SA(0, 1), cA + hstep, voffA);
        if (wr == 1) PG8_BAR;
        PG8_WAIT_V(2); PG8_BAR;
        PG8_STAGE(PG8_SB(1, 0), cB + kstep, voffB); PG8_STAGE(PG8_SA(1, 0), cA + kstep, voffA); PG8_STAGE(PG8_SB(1, 1), cB + hstep + kstep, voffB);
        PG8_WAIT_V(6); PG8_BAR;
    } else {
        PG8_STAGE(PG8_SB(0, 0), cB, voffB); PG8_STAGE(PG8_SA(0, 0), cA, voffA); PG8_STAGE(PG8_SB(0, 1), cB + hstep, voffB); PG8_STAGE(PG8_SA(0, 1), cA + hstep, voffA);
        if (wr == 1) PG8_BAR;
        PG8_WAIT_V(4); PG8_BAR;
        PG8_STAGE(PG8_SB(1, 0), cB + kstep, voffB); PG8_STAGE(PG8_SA(1, 0), cA + kstep, voffA); PG8_STAGE(PG8_SB(1, 1), cB + hstep + kstep, voffB);
        PG8_WAIT_V(6); PG8_BAR;
    }
    for (;;) {
        const bool has_next = S.next(ui + 1, nxt);
        const char* nA = has_next ? (const char*)g.A + (size_t)nxt.pa * tstep : cA; const char* nB = has_next ? (const char*)g.Bt + (size_t)nxt.pb * tstep : cB;
        for (int t = 0; t < nt; t += 2) {
            const bool last = (t == nt - 2);
            const char* a1 = cA + (size_t)(t + 1) * kstep;
            const char* a2 = last ? nA : cA + (size_t)(t + 2) * kstep; const char* b2 = last ? nB : cB + (size_t)(t + 2) * kstep;
            const char* a3 = a2 + kstep; const char* b3 = b2 + kstep;
            if (last && has_next) S.a_ready(nxt);
            if constexpr (SP2) {
            PG8_LDB(B0, 0, 0); PG8_LDB(B1, 0, 1); PG8_SCHED; PG8_LDA(At, 0, 0); PG8_STAGE(PG8_SA(1, 1), a1 + hstep, voffA);
            PG8_WAIT_V(8); PG8_WAIT_L(0); PG8_BAR; PG8_MMA(0, 0, At, B0); PG8_MMA(0, 1, At, B1); PG8_BAR; PG8_SCHED;
            PG8_LDA(At, 0, 1); PG8_STAGE(PG8_SB(0, 0), b2, voffB); PG8_STAGE(PG8_SB(0, 1), b2 + hstep, voffB); PG8_STAGE(PG8_SA(0, 0), a2, voffA);
            PG8_WAIT_V(8); PG8_WAIT_L(0); PG8_BAR; PG8_MMA(1, 0, At, B0); PG8_MMA(1, 1, At, B1); PG8_BAR; PG8_SCHED;
            PG8_LDB(B0, 1, 0); PG8_LDB(B1, 1, 1); PG8_SCHED; PG8_LDA(At, 1, 0); PG8_STAGE(PG8_SA(0, 1), a2 + hstep, voffA);
            PG8_WAIT_V(8); PG8_WAIT_L(0); PG8_BAR; PG8_MMA(0, 0, At, B0); PG8_MMA(0, 1, At, B1); PG8_BAR; PG8_SCHED;
            PG8_LDA(At, 1, 1); PG8_STAGE(PG8_SB(1, 0), b3, voffB); PG8_STAGE(PG8_SB(1, 1), b3 + hstep, voffB); PG8_STAGE(PG8_SA(1, 0), a3, voffA);
            PG8_WAIT_V(8); PG8_WAIT_L(0); PG8_BAR; PG8_MMA(1, 0, At, B0); PG8_MMA(1, 1, At, B1); PG8_BAR; PG8_SCHED;
            } else {
            PG8_LDB(B0, 0, 0); PG8_SCHED; PG8_LDA(At, 0, 0); PG8_STAGE(PG8_SA(1, 1), a1 + hstep, voffA);
            PG8_WAIT_L(8); PG8_BAR; PG8_WAIT_L(0); PG8_MMA(0, 0, At, B0); PG8_BAR; PG8_SCHED;
            PG8_LDB(B1, 0, 1); PG8_STAGE(PG8_SB(0, 0), b2, voffB);
            PG8_BAR; PG8_WAIT_L(0); PG8_MMA(0, 1, At, B1); PG8_BAR;
            PG8_LDA(At, 0, 1); PG8_STAGE(PG8_SA(0, 0), a2, voffA);
            PG8_BAR; PG8_WAIT_L(0); PG8_MMA(1, 0, At, B0); PG8_BAR; PG8_SCHED;
            PG8_STAGE(PG8_SB(0, 1), b2 + hstep, voffB);
            PG8_WAIT_V(6); PG8_BAR; PG8_MMA(1, 1, At, B1); PG8_BAR;
            PG8_LDB(B0, 1, 0); PG8_SCHED; PG8_LDA(At, 1, 0); PG8_STAGE(PG8_SA(0, 1), a2 + hstep, voffA);
            PG8_WAIT_L(8); PG8_BAR; PG8_WAIT_L(0); PG8_MMA(0, 0, At, B0); PG8_BAR; PG8_SCHED;
            PG8_LDB(B1, 1, 1); PG8_STAGE(PG8_SB(1, 0), b3, voffB);
            PG8_BAR; PG8_WAIT_L(0); PG8_MMA(0, 1, At, B1); PG8_BAR;
            PG8_LDA(At, 1, 1); PG8_STAGE(PG8_SA(1, 0), a3, voffA);
            PG8_BAR; PG8_WAIT_L(0); PG8_MMA(1, 0, At, B0); PG8_BAR; PG8_SCHED;
            PG8_STAGE(PG8_SB(1, 1), b3 + hstep, voffB);
            PG8_WAIT_V(6); PG8_BAR; PG8_MMA(1, 1, At, B1); PG8_BAR;
            }
        }
        if constexpr (ALIGN_EPI) { if (wr == 0) PG8_BAR; }
        if constexpr (!Epi::AFTER_DRAIN) { E(acc, cur, wr, wc, fr, fq); S.done(cur); }
        if (!has_next) break;
#pragma unroll
        for (int a = 0; a < 2; ++a)
#pragma unroll
            for (int b = 0; b < 2; ++b)
#pragma unroll
                for (int m = 0; m < 4; ++m)
#pragma unroll
                    for (int n = 0; n < 2; ++n) acc[a][b][m][n] = (f32x4){0.f, 0.f, 0.f, 0.f};
        cur = nxt; cA = nA; cB = nB; ++ui;
        if constexpr (ALIGN_EPI) { if (wr == 1) PG8_BAR; }
    }
    PG8_WAIT_V(0);
    if constexpr (!ALIGN_EPI) { if (wr == 0) PG8_BAR; }
    PG8_BAR;
    if constexpr (Epi::AFTER_DRAIN) { E.fused(acc, cur, wr, wc, fr, fq, lds, wid, lane); S.done(cur); }
#undef PG8_SA
#undef PG8_SB
#undef PG8_STAGE
#undef PG8_LDA
#undef PG8_LDB
#undef PG8_MMA
#undef PG8_WAIT_V
#undef PG8_WAIT_L
#undef PG8_BAR
#undef PG8_SCHED
}
}
#define PG8_SP2 true
#define PG8_ALIGN true

constexpr int BATCH = 2, SEQ = 16384, T = BATCH * SEQ, D = 1024, DEPTH = 4;
constexpr int NPROJ = 2304, NVT = 768;
constexpr int PC_U = 0, PC_RQ = 256, PC_RK = 768, PC_RG = 1280, PC_SQ = 1792, PC_SK = 2048, VT_RV = 0, VT_SV = 512;
constexpr int DFF = 2752, DFFP = 2816, EFF = 688, EFFP = 768, NE = 8;
constexpr int CH = 128, NUC = T / CH;
constexpr int MAXPAN = 264, MAXROWS = MAXPAN * 256;
constexpr float ALPHA = 1.6817928305074290f, LN_EPS = 1e-5f;
constexpr float SB_THR = 30.0f;

constexpr size_t MiB = 1u << 20;
constexpr size_t WS_CTL = 0, CTL_ZERO_BYTES = 1 * MiB;
constexpr size_t WS_WIN = 1 * MiB, WS_WOUT = 25 * MiB, WS_FGU = 33 * MiB, WS_FDN = 55 * MiB, WS_MGU = 66 * MiB, WS_MDN = 114 * MiB, WS_GLU = 138 * MiB;
constexpr size_t WS_ROPE = 139 * MiB;
constexpr size_t WS_S5LOC = 143 * MiB, WS_S5CAR = 145 * MiB;
constexpr size_t WS_MOE = 147 * MiB;
constexpr size_t MO_S5TAB = 1792 * 1024, MO_RETLG = 1920 * 1024;
constexpr size_t MO_SELE = 0, MO_SELR = 128 * 1024, MO_SELW = 256 * 1024, MO_TOKPOS = 512 * 1024, MO_ROWW = 768 * 1024, MO_COUNTS = 1280 * 1024, MO_PANEL = 1536 * 1024;
constexpr size_t WS_R1 = 149 * MiB;
constexpr size_t WS_VT = WS_R1 + 144 * MiB;
constexpr size_t WS_R2 = 341 * MiB;
constexpr size_t WS_RETLOC = WS_R2, WS_RETPREV = WS_R2 + 32 * MiB, WS_GBUF = WS_R2 + 48 * MiB;
constexpr size_t WS_R3 = 405 * MiB;
constexpr size_t WS_END = 469 * MiB;
static_assert((size_t)MAXROWS * EFFP * 2 <= 128 * MiB && (size_t)MAXROWS * 1024 * 2 <= 192 * MiB && (size_t)T * DFFP * 2 <= 192 * MiB, "overlay sizes");
constexpr int CW_TMO = 0, CW_NP = 64, CW_BAR = 4096;

constexpr int RING_OFF = 0, RING_BYTES = 131072;
constexpr int LDSCTL_OFF = 146432, MISC_OFF = LDSCTL_OFF + 320;
constexpr int LDS_BYTES = 147456;
constexpr int NWAVES = 8;

#define GAS __attribute__((address_space(1)))
#define LAS __attribute__((address_space(3)))
typedef unsigned short bf16;
typedef unsigned u32x4 __attribute__((ext_vector_type(4)));
typedef unsigned u32x2 __attribute__((ext_vector_type(2)));
typedef float f32x4 __attribute__((ext_vector_type(4)));
typedef float f32x2 __attribute__((ext_vector_type(2)));
typedef float f32x16 __attribute__((ext_vector_type(16)));
typedef short bf16x8 __attribute__((ext_vector_type(8)));
typedef GAS unsigned gu32;
#define RLX_AGENT __ATOMIC_RELAXED, __HIP_MEMORY_SCOPE_AGENT
#define LDS_WAIT() asm volatile("s_waitcnt lgkmcnt(0)" ::: "memory")
#define VM_WAIT() asm volatile("s_waitcnt vmcnt(0)" ::: "memory")

#define XB_TMO      128
#define XB_XCNT(j)  (256  + 64 * (j))
#define XB_XSUB(j)  (1280 + 64 * (j))
#define XB_XGEN(j)  (2304 + 64 * (j))
#define XB_TOP      3328
#define XB_TOPGEN   3392
#define XCD_BAR_WORDS 3456
#define XB_SPIN_CAP (1u << 18)

__device__ __forceinline__ unsigned xb_ld(unsigned* p)              { return __hip_atomic_load(p, __ATOMIC_RELAXED, __HIP_MEMORY_SCOPE_AGENT); }
__device__ __forceinline__ unsigned xb_add(unsigned* p, unsigned v) { return __hip_atomic_fetch_add(p, v, __ATOMIC_RELAXED, __HIP_MEMORY_SCOPE_AGENT); }
__device__ __forceinline__ unsigned xb_xcc_id() { return (unsigned)__builtin_amdgcn_s_getreg((3 << 11) | 20) & 0xFu; }
#define XB_SPIN(cond, bar) do { unsigned _sp = 0; while (cond) { __builtin_amdgcn_s_sleep(1); \
    if ((++_sp & 255u) == 0u) { if (xb_ld(&(bar)[XB_TMO])) break; if (_sp > XB_SPIN_CAP) { atomicAdd(&(bar)[XB_TMO], 1u); break; } } } } while (0)

struct XcdBarrier {
    unsigned* bar; unsigned x;
    volatile LAS unsigned* st;
};

__device__ __forceinline__ XcdBarrier xcd_barrier_post(unsigned* bar, volatile LAS unsigned* st) {
    XcdBarrier b; b.bar = bar; b.x = xb_xcc_id(); b.st = st;
    if (threadIdx.x == 0) (void)xb_add(&bar[XB_XCNT(b.x)], 1u);
    return b;
}
__device__ __forceinline__ void xcd_barrier_complete(unsigned* bar, unsigned x, unsigned& nloc, unsigned& nx) {
    const unsigned G = gridDim.x * gridDim.y * gridDim.z;
    unsigned sum, cnt, mine, sp = 0u;
    for (;;) {
        sum = 0u; cnt = 0u; mine = 0u;
#pragma unroll
        for (unsigned j = 0; j < 16; ++j) { const unsigned c = xb_ld(&bar[XB_XCNT(j)]); sum += c; cnt += (c > 0u) ? 1u : 0u; mine = (j == x) ? c : mine; }
        if (sum == G) break;
        __builtin_amdgcn_s_sleep(1);
        if ((++sp & 255u) == 0u) { if (xb_ld(&bar[XB_TMO])) break; if (sp > XB_SPIN_CAP) { atomicAdd(&bar[XB_TMO], 1u); break; } }
    }
    nloc = mine > 0u ? mine : 1u; nx = cnt > 0u ? cnt : 1u;
}

__device__ __forceinline__ void xcd_barrier(const XcdBarrier& b) {
    asm volatile("s_waitcnt vmcnt(0)" ::: "memory");
    __syncthreads();
    if (threadIdx.x == 0) {
        unsigned* bar = b.bar; asm volatile("" : "+s"(bar));
        __builtin_amdgcn_s_waitcnt(0);
        unsigned nloc = b.st[0], nx = b.st[1];
        if (nloc == 0u) { xcd_barrier_complete(bar, b.x, nloc, nx); b.st[0] = nloc; b.st[1] = nx; }
        const unsigned old = xb_add(&bar[XB_XSUB(b.x)], 1u);
        const unsigned gen = old / nloc;
        if (old + 1u == (gen + 1u) * nloc) {
            __builtin_amdgcn_fence(__ATOMIC_RELEASE, "agent");
            asm volatile("s_waitcnt vmcnt(0)" ::: "memory");
            const unsigned og = xb_add(&bar[XB_TOP], 1u);
            const unsigned tg = og / nx;
            if (og + 1u == (tg + 1u) * nx) xb_add(&bar[XB_TOPGEN], 1u);
            else XB_SPIN(xb_ld(&bar[XB_TOPGEN]) == tg, bar);
            __builtin_amdgcn_fence(__ATOMIC_ACQUIRE, "agent");
            xb_add(&bar[XB_XGEN(b.x)], 1u);
            asm volatile("s_waitcnt vmcnt(0)" ::: "memory");
        } else {
            XB_SPIN(xb_ld(&bar[XB_XGEN(b.x)]) == gen, bar);
            __builtin_amdgcn_fence(__ATOMIC_ACQUIRE, "agent");
            asm volatile("s_waitcnt vmcnt(0)" ::: "memory");
        }
    }
    __syncthreads();
}

__device__ __forceinline__ float bf2f(unsigned short b) { return __uint_as_float(((unsigned)b) << 16); }
__device__ __forceinline__ unsigned cvtpk(float lo, float hi) { return pg8::cvt_pk_bf16(lo, hi); }
__device__ __forceinline__ float wave_sum(float v) {
#pragma unroll
    for (int o = 1; o < 64; o <<= 1) v += __shfl_xor(v, o);
    return v;
}
__device__ __forceinline__ int wave_sum_i(int v) {
#pragma unroll
    for (int o = 1; o < 64; o <<= 1) v += __shfl_xor(v, o);
    return v;
}
__device__ __forceinline__ bf16x8 ld8(const bf16* p) { return __builtin_bit_cast(bf16x8, *(const u32x4*)p); }
__device__ __forceinline__ bf16x8 pack8(const float* a) { u32x4 w; w.x = cvtpk(a[0], a[1]); w.y = cvtpk(a[2], a[3]); w.z = cvtpk(a[4], a[5]); w.w = cvtpk(a[6], a[7]); return __builtin_bit_cast(bf16x8, w); }
__device__ __forceinline__ void unpack8(const u32x4 r, float* o) {
    o[0] = __uint_as_float(r.x << 16); o[1] = __uint_as_float(r.x & 0xffff0000u); o[2] = __uint_as_float(r.y << 16); o[3] = __uint_as_float(r.y & 0xffff0000u);
    o[4] = __uint_as_float(r.z << 16); o[5] = __uint_as_float(r.z & 0xffff0000u); o[6] = __uint_as_float(r.w << 16); o[7] = __uint_as_float(r.w & 0xffff0000u);
}
__device__ __forceinline__ int tau(int r) { return 16 * ((r >> 2) & 1) + 4 * (r >> 3) + (r & 3); }
#define MFMA32(a, b, c) __builtin_amdgcn_mfma_f32_32x32x16_bf16(a, b, c, 0, 0, 0)
#define MFMA16(a, b, c) __builtin_amdgcn_mfma_f32_16x16x32_bf16(a, b, c, 0, 0, 0)
__device__ __forceinline__ float gelu_tanh(float x) {
    const float a = 0.7978845608028654f * (x + 0.044715f * x * x * x);
    const float th = 1.0f - 2.0f * __builtin_amdgcn_rcpf(1.0f + __expf(2.0f * a));
    return 0.5f * x * (1.0f + th);
}

struct Args { const float* in[28]; float* out; unsigned char* ws; };
typedef const __attribute__((address_space(4))) Args* ArgsP;
enum { I_X = 0, I_WIN, I_LAMRE, I_LAMIM, I_LOGDT, I_BRE, I_BIM, I_CRE, I_CIM, I_SSMD, I_GLUW, I_GLUB, I_SSMNW, I_RETGW, I_RETGB, I_SBNW, I_WOUT, I_LNMW, I_LNMB,
       I_FG, I_FU, I_FD, I_ROUTER, I_MG, I_MU, I_MD, I_LNFW, I_LNFB };

__device__ __forceinline__ void tr_item(const float* W, int Ks, int Ns, bf16* WT, int Kd, int k0, int n0, int drow0, LAS float* scr, int lane) {
    float tv[32];
#pragma unroll
    for (int i = 0; i < 32; ++i) { const int kk = 2 * i + (lane >> 5), k = k0 + kk, n = n0 + (lane & 31); tv[i] = (k < Ks && n < Ns) ? W[(size_t)k * Ns + n] : 0.f; }
#pragma unroll
    for (int i = 0; i < 32; ++i) scr[(2 * i + (lane >> 5)) * 33 + (lane & 31)] = tv[i];
    LDS_WAIT(); asm volatile("" ::: "memory");
    const int c = lane & 7;
#pragma unroll
    for (int j = 0; j < 4; ++j) { const int n = (lane >> 3) + 8 * j; const LAS float* s = scr + (8 * c) * 33 + n;
        u32x4 o; o.x = cvtpk(s[0 * 33], s[1 * 33]); o.y = cvtpk(s[2 * 33], s[3 * 33]); o.z = cvtpk(s[4 * 33], s[5 * 33]); o.w = cvtpk(s[6 * 33], s[7 * 33]);
        *(u32x4*)(WT + (size_t)(drow0 + n) * Kd + k0 + 8 * c) = o; }
    LDS_WAIT(); asm volatile("" ::: "memory");
}
__device__ __forceinline__ void p0_prologue(ArgsP a, LAS unsigned char* lds, int tid, int lane, int wave) {
    unsigned char* ws = a->ws;
    LAS float* scr = (LAS float*)(lds + wave * 16384);
    const int gw = blockIdx.x * NWAVES + wave, NGW = gridDim.x * NWAVES;
    constexpr int NA = 4 * 1536, NB = 4 * 512, NC = 2 * 2816, ND = 2 * 1408, NEE = 16 * 768, NF = 16 * 384, NG = 4 * 32;
    constexpr int NITEMS = NA + NB + NC + ND + NEE + NF + NG;
    for (int it = gw; it < NITEMS; it += NGW) {
        int r = it;
        if (r < NA) { const int l = r / 1536, q = r % 1536, kb = q / 96, nb = q % 96, c = 32 * nb;
            const int drow = c < 1280 ? c : (c < 1792 ? 2304 + (c - 1280) : (c < 2816 ? c - 512 : c));
            tr_item(a->in[I_WIN] + (size_t)l * 1024 * 3072, 1024, 3072, (bf16*)(ws + WS_WIN) + (size_t)l * 3072 * 1024, 1024, 64 * kb, c, drow, scr, lane); continue; }
        r -= NA;
        if (r < NB) { const int l = r / 512, q = r % 512, kb = q / 32, nb = q % 32;
            tr_item(a->in[I_WOUT] + (size_t)l * 1024 * 1024, 1024, 1024, (bf16*)(ws + WS_WOUT) + (size_t)l * 1024 * 1024, 1024, 64 * kb, 32 * nb, 32 * nb, scr, lane); continue; }
        r -= NB;
        if (r < NC) { const int li = r / 2816, q = r % 2816, db = q / 16, kb = q % 16, pn = db >> 3, wi = db & 7, ffc = 128 * pn + 32 * (wi & 3);
            const float* src = (wi >> 2) ? a->in[I_FU] : a->in[I_FG];
            tr_item(src + (size_t)li * 1024 * DFF, 1024, DFF, (bf16*)(ws + WS_FGU) + (size_t)li * 5632 * 1024, 1024, 64 * kb, ffc, 32 * db, scr, lane); continue; }
        r -= NC;
        if (r < ND) { const int li = r / 1408, q = r % 1408, kb = q / 32, nb = q % 32;
            tr_item(a->in[I_FD] + (size_t)li * DFF * 1024, DFF, 1024, (bf16*)(ws + WS_FDN) + (size_t)li * 1024 * DFFP, DFFP, 64 * kb, 32 * nb, 32 * nb, scr, lane); continue; }
        r -= ND;
        if (r < NEE) { const int le = r / 768, q = r % 768, db = q / 16, kb = q % 16, pn = db >> 3, wi = db & 7, ffc = 128 * pn + 32 * (wi & 3);
            const float* src = (wi >> 2) ? a->in[I_MU] : a->in[I_MG];
            tr_item(src + (size_t)le * 1024 * EFF, 1024, EFF, (bf16*)(ws + WS_MGU) + (size_t)le * 1536 * 1024, 1024, 64 * kb, ffc, 32 * db, scr, lane); continue; }
        r -= NEE;
        if (r < NF) { const int le = r / 384, q = r % 384, kb = q / 32, nb = q % 32;
            tr_item(a->in[I_MD] + (size_t)le * EFF * 1024, EFF, 1024, (bf16*)(ws + WS_MDN) + (size_t)le * 1024 * EFFP, EFFP, 64 * kb, 32 * nb, 32 * nb, scr, lane); continue; }
        r -= NF;
        { const int l = r / 32, q = r % 32, kb = q / 8, nb = q % 8;
            tr_item(a->in[I_GLUW] + (size_t)l * 65536, 256, 256, (bf16*)(ws + WS_GLU) + (size_t)l * 65536, 256, 64 * kb, 32 * nb, 32 * nb, scr, lane); }
    }
    { const f32x4* x4 = (const f32x4*)a->in[I_X]; u32x4* o = (u32x4*)(ws + WS_R2);
      const size_t n8 = (size_t)T * D / 8, gt = (size_t)blockIdx.x * (NWAVES * 64) + tid, GT = (size_t)gridDim.x * NWAVES * 64;
      for (size_t i = gt; i < n8; i += GT) { const f32x4 v0 = x4[2 * i], v1 = x4[2 * i + 1]; u32x4 w; w.x = cvtpk(v0[0], v0[1]); w.y = cvtpk(v0[2], v0[3]); w.z = cvtpk(v1[0], v1[1]); w.w = cvtpk(v1[2], v1[3]); o[i] = w; } }
    { float* tab = (float*)(ws + WS_MOE + MO_S5TAB);
      const int gt = blockIdx.x * (NWAVES * 64) + tid, GT = gridDim.x * NWAVES * 64;
      for (int i = gt; i < DEPTH * 16 * 64; i += GT) { const int lg = i >> 6;
          const float lr = a->in[I_LAMRE][i], li = a->in[I_LAMIM][i], dt = expf(a->in[I_LOGDT][lg]);
          const float zr = lr * dt, zi = li * dt; float sn, cs; sincosf(zi, &sn, &cs);
          const float mag = expf(zr), ar = mag * cs, ai = mag * sn;
          const float sh = sinf(0.5f * zi); const float mr = expm1f(zr) * cs - 2.0f * sh * sh, mi = ai;
          const float den = 1.0f / (lr * lr + li * li);
          const float cr = (mr * lr + mi * li) * den, ci = (mi * lr - mr * li) * den;
          const double zr128 = (double)lr * (double)dt * 128.0, zi128 = (double)li * (double)dt * 128.0; const double m128 = exp(zr128);
          f32x4* o = (f32x4*)(tab + (size_t)i * 8); o[0] = (f32x4){ar, ai, cr, ci}; o[1] = (f32x4){(float)(m128 * cos(zi128)), (float)(m128 * sin(zi128)), 0.f, 0.f}; }
      if (gt < 8) ((float*)(ws + WS_MOE + MO_RETLG))[gt] = (float)log2(1.0 - exp2(-5.0 - (double)gt)); }
    { float* ct = (float*)(ws + WS_ROPE); float* st = ct + SEQ * 32;
      const int gt = blockIdx.x * (NWAVES * 64) + tid, GT = gridDim.x * NWAVES * 64;
      for (int i = gt; i < SEQ * 32; i += GT) { const int pos = i >> 5, f = i & 31; const double inv = exp(-(double)f * (9.210340371976184 / 32.0)); const double ang = (double)pos * inv;
          ct[i] = (float)cos(ang); st[i] = (float)sin(ang); } }
}

template <int MODE>
__device__ __forceinline__ void ln_phase(ArgsP a, const float* lnw, const float* lnb, const float* wrouter, LAS unsigned char* lds, int tid, int lane, int wave) {
    unsigned char* ws = a->ws;
    float* out = a->out; bf16* xb = (bf16*)(ws + WS_R2);
    f32x4 wv[4], bv[4];
#pragma unroll
    for (int j = 0; j < 4; ++j) { wv[j] = ((const f32x4*)lnw)[lane + 64 * j]; bv[j] = ((const f32x4*)lnb)[lane + 64 * j]; }
    LAS float* wrs = (LAS float*)lds; LAS int* cnt = (LAS int*)(lds + 32768);
    if (MODE == 1) {
        for (int i = tid; i < 8192; i += NWAVES * 64) { const int c = i >> 3, e = i & 7; wrs[e * 1024 + c] = wrouter[i]; }
        if (tid < 8) cnt[tid] = 0;
        __syncthreads();
    }
    unsigned* selE = (unsigned*)(ws + WS_MOE + MO_SELE); unsigned* selR = (unsigned*)(ws + WS_MOE + MO_SELR); f32x2* selW = (f32x2*)(ws + WS_MOE + MO_SELW);
    const u32x2* tokpos = (const u32x2*)(ws + WS_MOE + MO_TOKPOS); int* counts = (int*)(ws + WS_MOE + MO_COUNTS);
    const bf16* ymoe = (const bf16*)(ws + WS_R1);
    for (int rb = blockIdx.x; rb < NUC; rb += gridDim.x) {
        const int m0 = rb * 128 + wave * 16;
        u32x2 tpl = {0u, 0u}; if (MODE == 2) tpl = tokpos[m0 + (lane & 15)];
        f32x4 nv[4]; u32x2 ny0[4], ny1[4];
        { const f32x4* xr0 = (const f32x4*)(out + (size_t)m0 * D) + lane;
#pragma unroll
          for (int j = 0; j < 4; ++j) nv[j] = xr0[64 * j];
          if (MODE == 2) { const unsigned p0 = __shfl(tpl.x, 0), p1 = __shfl(tpl.y, 0); const u32x2* y0 = (const u32x2*)(ymoe + (size_t)p0 * D) + lane; const u32x2* y1 = (const u32x2*)(ymoe + (size_t)p1 * D) + lane;
#pragma unroll
              for (int j = 0; j < 4; ++j) { ny0[j] = y0[64 * j]; ny1[j] = y1[64 * j]; } } }
        for (int rr = 0; rr < 16; ++rr) {
            const int m = m0 + rr;
            f32x4* xr = (f32x4*)(out + (size_t)m * D) + lane;
            f32x4 v[4]; float s = 0.f;
#pragma unroll
            for (int j = 0; j < 4; ++j) v[j] = nv[j];
            if (MODE == 2) {
#pragma unroll
                for (int j = 0; j < 4; ++j) { const u32x2 p0 = ny0[j], p1 = ny1[j];
                    v[j][0] = ALPHA * v[j][0] + __uint_as_float(p0.x << 16) + __uint_as_float(p1.x << 16);
                    v[j][1] = ALPHA * v[j][1] + __uint_as_float(p0.x & 0xffff0000u) + __uint_as_float(p1.x & 0xffff0000u);
                    v[j][2] = ALPHA * v[j][2] + __uint_as_float(p0.y << 16) + __uint_as_float(p1.y << 16);
                    v[j][3] = ALPHA * v[j][3] + __uint_as_float(p0.y & 0xffff0000u) + __uint_as_float(p1.y & 0xffff0000u); }
            }
            if (rr < 15) {
                const f32x4* xn = (const f32x4*)(out + (size_t)(m + 1) * D) + lane;
#pragma unroll
                for (int j = 0; j < 4; ++j) nv[j] = xn[64 * j];
                if (MODE == 2) { const unsigned p0 = __shfl(tpl.x, rr + 1), p1 = __shfl(tpl.y, rr + 1); const u32x2* y0 = (const u32x2*)(ymoe + (size_t)p0 * D) + lane; const u32x2* y1 = (const u32x2*)(ymoe + (size_t)p1 * D) + lane;
#pragma unroll
                    for (int j = 0; j < 4; ++j) { ny0[j] = y0[64 * j]; ny1[j] = y1[64 * j]; } }
            }
#pragma unroll
            for (int j = 0; j < 4; ++j) s += (v[j][0] + v[j][1]) + (v[j][2] + v[j][3]);
            const float mean = wave_sum(s) * (1.f / D); float s2 = 0.f;
#pragma unroll
            for (int j = 0; j < 4; ++j) { v[j] = v[j] - mean; s2 += (v[j][0] * v[j][0] + v[j][1] * v[j][1]) + (v[j][2] * v[j][2] + v[j][3] * v[j][3]); }
            const float rstd = __builtin_amdgcn_rsqf(wave_sum(s2) * (1.f / D) + LN_EPS);
            u32x2* o8 = (u32x2*)(xb + (size_t)m * D) + lane;
#pragma unroll
            for (int j = 0; j < 4; ++j) { v[j] = v[j] * rstd * wv[j] + bv[j]; xr[64 * j] = v[j]; u32x2 w; w.x = cvtpk(v[j][0], v[j][1]); w.y = cvtpk(v[j][2], v[j][3]); o8[64 * j] = w; }
            if (MODE == 1) {
                float lg[8];
#pragma unroll
                for (int e = 0; e < 8; ++e) { float p = 0.f;
#pragma unroll
                    for (int j = 0; j < 4; ++j) { const f32x4 w4 = *(const LAS f32x4*)(wrs + e * 1024 + 4 * lane + 256 * j); p += (v[j][0] * w4[0] + v[j][1] * w4[1]) + (v[j][2] * w4[2] + v[j][3] * w4[3]); }
                    lg[e] = wave_sum(p); }
                float best = lg[0]; int e0 = 0;
#pragma unroll
                for (int e = 1; e < 8; ++e) if (lg[e] > best) { best = lg[e]; e0 = e; }
                float sec = -3.0e38f; int e1 = 0;
#pragma unroll
                for (int e = 0; e < 8; ++e) if (e != e0 && lg[e] > sec) { sec = lg[e]; e1 = e; }
                if (lane == 0) {
                    const float w0 = __builtin_amdgcn_rcpf(1.0f + __expf(sec - best));
                    const int lr0 = atomicAdd((int*)&cnt[e0], 1), lr1 = atomicAdd((int*)&cnt[e1], 1);
                    selE[m] = (unsigned)e0 | ((unsigned)e1 << 8); selR[m] = (unsigned)lr0 | ((unsigned)lr1 << 16); selW[m] = (f32x2){w0, 1.0f - w0};
                }
            }
        }
        if (MODE == 1) {
            __syncthreads();
            if (tid < 8) { counts[rb * 8 + tid] = cnt[tid]; cnt[tid] = 0; }
            __syncthreads();
        }
    }
}

__device__ __forceinline__ void moe_gather_phase(ArgsP a, LAS unsigned char* lds, int tid, int lane, int wave) {
    unsigned char* ws = a->ws;
    const unsigned* selE = (const unsigned*)(ws + WS_MOE + MO_SELE); const unsigned* selR = (const unsigned*)(ws + WS_MOE + MO_SELR); const f32x2* selW = (const f32x2*)(ws + WS_MOE + MO_SELW);
    u32x2* tokpos = (u32x2*)(ws + WS_MOE + MO_TOKPOS); float* roww = (float*)(ws + WS_MOE + MO_ROWW); const int* counts = (const int*)(ws + WS_MOE + MO_COUNTS); int* panel_exp = (int*)(ws + WS_MOE + MO_PANEL);
    const bf16* xb = (const bf16*)(ws + WS_R2); bf16* Ag = (bf16*)(ws + WS_R1);
    LAS int* sTot = (LAS int*)lds; LAS int* sPre = sTot + 8; LAS int* sBase = sTot + 16; LAS int* sEb = sTot + 24; LAS int* sPad = sTot + 32;
    for (int rb = blockIdx.x; rb < NUC; rb += gridDim.x) {
        { int tot = 0, pre = 0;
          for (int k = lane; k < NUC; k += 64) { const int cv = counts[k * 8 + wave]; tot += cv; if (k < rb) pre += cv; }
          tot = wave_sum_i(tot); pre = wave_sum_i(pre);
          if (lane == 0) { sTot[wave] = tot; sPre[wave] = pre; } }
        __syncthreads();
        if (tid == 0) { int eb = 0;
            for (int e = 0; e < 8; ++e) { const int pad = ((sTot[e] + 255) >> 8) << 8; sEb[e] = eb; sBase[e] = eb + sPre[e]; sPad[e] = pad; eb += pad; }
            if (rb == 0) { int p = 0; for (int e = 0; e < 8; ++e) for (int k = 0; k < (sPad[e] >> 8); ++k) panel_exp[p++] = e;
                __hip_atomic_store((unsigned*)ws + CW_NP, (unsigned)p, RLX_AGENT); } }
        __syncthreads();
        { const int m0 = rb * 128 + wave * 16;
          const unsigned sel = selE[m0 + (lane & 15)], srl = selR[m0 + (lane & 15)]; const f32x2 wl = selW[m0 + (lane & 15)];
          const unsigned p0l = sBase[sel & 255] + (srl & 0xffffu), p1l = sBase[(sel >> 8) & 255] + (srl >> 16);
          if (lane < 16) { roww[p0l] = wl.x; roww[p1l] = wl.y; tokpos[m0 + lane] = (u32x2){p0l, p1l}; }
          const u32x4* src0 = (const u32x4*)(xb + (size_t)m0 * D); u32x4 n0 = src0[lane], n1 = src0[lane + 64];
          for (int rr = 0; rr < 16; ++rr) {
              const u32x4 c0 = n0, c1 = n1;
              if (rr < 15) { const u32x4* src = (const u32x4*)(xb + (size_t)(m0 + rr + 1) * D); n0 = src[lane]; n1 = src[lane + 64]; }
              const unsigned pos0 = __shfl(p0l, rr), pos1 = __shfl(p1l, rr);
              u32x4* d0 = (u32x4*)(Ag + (size_t)pos0 * D); u32x4* d1 = (u32x4*)(Ag + (size_t)pos1 * D);
              d0[lane] = c0; d0[lane + 64] = c1; d1[lane] = c0; d1[lane + 64] = c1;
          } }
        if (rb < 8) { const int e = rb, n0 = sEb[e] + sTot[e], n1 = sEb[e] + sPad[e];
            for (int r = n0 + wave; r < n1; r += NWAVES) { u32x4* d = (u32x4*)(Ag + (size_t)r * D); d[lane] = (u32x4){0u, 0u, 0u, 0u}; d[lane + 64] = (u32x4){0u, 0u, 0u, 0u}; if (lane == 0) roww[r] = 0.f; } }
        __syncthreads();
    }
}

template <bool APPLY>
__device__ __forceinline__ void s5_unit(ArgsP a, int l, int uc, LAS unsigned char* lds, int tid, int lane, int wave) {
    unsigned char* ws = a->ws;
    const bf16* proj = (const bf16*)(ws + WS_R1);
    const int R0 = uc * CH;
    LAS unsigned char* UT = lds;
    LAS unsigned char* XS = lds + 65536 + wave * 8704;
#pragma unroll
    for (int i = 0; i < 8; ++i) { const int idx = tid + 512 * i, r = idx >> 5, ch = idx & 31;
        *(LAS u32x4*)(UT + r * 512 + ch * 16) = *(const u32x4*)(proj + (size_t)(R0 + r) * NPROJ + PC_U + ch * 8); }
    __syncthreads();
    const int cl = lane & 31, hh = lane >> 5, g0 = 2 * wave, lg0 = l * 16 + g0;
    const float* tab = (const float*)(ws + WS_MOE + MO_S5TAB);
    bf16x8 bb[2][4];
#pragma unroll
    for (int gi = 0; gi < 2; ++gi)
#pragma unroll
        for (int pc = 0; pc < 2; ++pc) { const int gp = (lg0 + gi) * 64 + 32 * pc + cl;
            const f32x4 t4 = *(const f32x4*)(tab + (size_t)gp * 8); const float cr = t4[2], ci = t4[3];
            const f32x4 r0 = *(const f32x4*)(a->in[I_BRE] + (size_t)gp * 16 + 8 * hh), r1 = *(const f32x4*)(a->in[I_BRE] + (size_t)gp * 16 + 8 * hh + 4);
            const f32x4 i0 = *(const f32x4*)(a->in[I_BIM] + (size_t)gp * 16 + 8 * hh), i1 = *(const f32x4*)(a->in[I_BIM] + (size_t)gp * 16 + 8 * hh + 4);
            float re[8], im[8];
#pragma unroll
            for (int j = 0; j < 4; ++j) { re[j] = cr * r0[j] - ci * i0[j]; im[j] = cr * i0[j] + ci * r0[j]; re[4 + j] = cr * r1[j] - ci * i1[j]; im[4 + j] = cr * i1[j] + ci * r1[j]; }
            bb[gi][pc] = pack8(re); bb[gi][2 + pc] = pack8(im); }
    float ar[2], ai[2], xr[2], xi[2];
#pragma unroll
    for (int pc = 0; pc < 2; ++pc) { const int gp = (lg0 + hh) * 64 + 32 * pc + cl; const f32x2 t2 = *(const f32x2*)(tab + (size_t)gp * 8); ar[pc] = t2.x; ai[pc] = t2.y; xr[pc] = 0.f; xi[pc] = 0.f;
        if (APPLY) { const f32x2 c0 = ((const f32x2*)(ws + WS_S5CAR))[(size_t)(uc * 16 + g0 + hh) * 64 + 32 * pc + cl]; xr[pc] = c0.x; xi[pc] = c0.y; } }
    bf16x8 cb[2][4]; float dsk[2] = {0.f, 0.f};
    if (APPLY) { const int h = lane & 15;
#pragma unroll
        for (int gi = 0; gi < 2; ++gi) {
#pragma unroll
            for (int s = 0; s < 4; ++s) { const int pp = 4 * (lane >> 4) + 16 * s;
                const f32x4 re = *(const f32x4*)(a->in[I_CRE] + (size_t)((lg0 + gi) * 16 + h) * 64 + pp), im = *(const f32x4*)(a->in[I_CIM] + (size_t)((lg0 + gi) * 16 + h) * 64 + pp);
                float tmp[8] = {re[0], -im[0], re[1], -im[1], re[2], -im[2], re[3], -im[3]}; cb[gi][s] = pack8(tmp); }
            dsk[gi] = a->in[I_SSMD][l * 256 + (g0 + gi) * 16 + h]; } }
    const int tr = tau(cl), gh = tr >> 4, ti = tr & 15;
    const LAS unsigned char* ua = UT + ti * 512 + ((g0 + gh) * 16 + 8 * hh) * 2;
    for (int tb = 0; tb < 8; ++tb) {
        const u32x4 uraw = *(const LAS u32x4*)(ua + tb * 16 * 512);
        const u32x4 z4 = {0u, 0u, 0u, 0u};
        const bf16x8 a0 = __builtin_bit_cast(bf16x8, gh == 0 ? uraw : z4), a1 = __builtin_bit_cast(bf16x8, gh == 1 ? uraw : z4);
        f32x16 bu[4];
#pragma unroll
        for (int c = 0; c < 4; ++c) {
#pragma unroll
            for (int k = 0; k < 16; ++k) bu[c][k] = 0.f;
            bu[c] = MFMA32(a0, bb[0][c], bu[c]); bu[c] = MFMA32(a1, bb[1][c], bu[c]); }
#pragma unroll
        for (int i = 0; i < 16; ++i) {
#pragma unroll
            for (int pc = 0; pc < 2; ++pc) { const float nr = ar[pc] * xr[pc] - ai[pc] * xi[pc] + bu[pc][i], ni = ar[pc] * xi[pc] + ai[pc] * xr[pc] + bu[2 + pc][i]; xr[pc] = nr; xi[pc] = ni;
                if (APPLY) *(LAS unsigned*)(XS + hh * 4352 + i * 272 + (32 * pc + cl) * 4) = cvtpk(nr, ni); }
        }
        if (APPLY) {
            LDS_WAIT();
            const int h = lane & 15;
#pragma unroll
            for (int gi = 0; gi < 2; ++gi) {
                f32x4 y = {0.f, 0.f, 0.f, 0.f};
#pragma unroll
                for (int s = 0; s < 4; ++s) { const bf16x8 xa = *(const LAS bf16x8*)(XS + gi * 4352 + (lane & 15) * 272 + ((lane >> 4) * 8 + 32 * s) * 2); y = MFMA16(xa, cb[gi][s], y); }
#pragma unroll
                for (int r = 0; r < 4; ++r) { const int t = tb * 16 + 4 * (lane >> 4) + r; LAS unsigned short* up = (LAS unsigned short*)(UT + t * 512 + ((g0 + gi) * 16 + h) * 2);
                    const float yy = y[r] + dsk[gi] * bf2f(*up); *up = (unsigned short)(cvtpk(gelu_tanh(yy), 0.f) & 0xffffu); }
            }
            LDS_WAIT();
        }
    }
    if (!APPLY) {
#pragma unroll
        for (int pc = 0; pc < 2; ++pc) ((f32x2*)(ws + WS_S5LOC))[(size_t)(uc * 16 + g0 + hh) * 64 + 32 * pc + cl] = (f32x2){xr[pc], xi[pc]};
    }
    if (APPLY) {
        __syncthreads();
        bf16* gbuf = (bf16*)(ws + WS_GBUF);
#pragma unroll
        for (int i = 0; i < 8; ++i) { const int idx = tid + 512 * i, r = idx >> 5, ch = idx & 31;
            *(u32x4*)(gbuf + (size_t)(R0 + r) * 256 + ch * 8) = *(const LAS u32x4*)(UT + r * 512 + ch * 16); }
    }
    __syncthreads();
}

__device__ __forceinline__ void load_rope(const bf16* rowp, const float* cosr, const float* sinr, int hh, float scale, bf16x8 (&o)[4]) {
    u32x4 raw[4];
#pragma unroll
    for (int s = 0; s < 4; ++s) raw[s] = *(const u32x4*)(rowp + 16 * s + 8 * hh);
#pragma unroll
    for (int s = 0; s < 2; ++s) {
        float x1[8], x2[8], c[8], sn[8], y1[8], y2[8]; unpack8(raw[s], x1); unpack8(raw[s + 2], x2);
        const f32x4 c0 = *(const f32x4*)(cosr + 16 * s + 8 * hh), c1 = *(const f32x4*)(cosr + 16 * s + 8 * hh + 4), s0 = *(const f32x4*)(sinr + 16 * s + 8 * hh), s1 = *(const f32x4*)(sinr + 16 * s + 8 * hh + 4);
#pragma unroll
        for (int j = 0; j < 4; ++j) { c[j] = c0[j]; c[4 + j] = c1[j]; sn[j] = s0[j]; sn[4 + j] = s1[j]; }
#pragma unroll
        for (int j = 0; j < 8; ++j) { y1[j] = (x1[j] * c[j] - x2[j] * sn[j]) * scale; y2[j] = (x1[j] * sn[j] + x2[j] * c[j]) * scale; }
        o[s] = pack8(y1); o[s + 2] = pack8(y2);
    }
}

__device__ __forceinline__ void ret_local_unit(ArgsP a, int uc, int lane, int h) {
    unsigned char* ws = a->ws;
    const bf16* proj = (const bf16*)(ws + WS_R1); const bf16* vT = (const bf16*)(ws + WS_VT);
    const float* cost = (const float*)(ws + WS_ROPE); const float* sint = cost + SEQ * 32;
    const int R0 = uc * CH, s0 = (uc & 127) * CH, cl = lane & 31, hh = lane >> 5;
    const float lg2 = ((const float*)(ws + WS_MOE + MO_RETLG))[h];
    f32x16 kv[2][2];
#pragma unroll
    for (int i = 0; i < 2; ++i)
#pragma unroll
        for (int j = 0; j < 2; ++j)
#pragma unroll
            for (int k = 0; k < 16; ++k) kv[i][j][k] = 0.f;
    bf16x8 idm[2];
#pragma unroll
    for (int s2 = 0; s2 < 2; ++s2) { float t8[8];
#pragma unroll
        for (int j = 0; j < 8; ++j) t8[j] = (16 * s2 + 8 * hh + j == cl) ? 1.0f : 0.0f;
        idm[s2] = pack8(t8); }
#pragma unroll
    for (int ti = 0; ti < 4; ++ti) {
        const int tl = 32 * ti + tau(cl);
        bf16x8 ka[4]; load_rope(proj + (size_t)(R0 + tl) * NPROJ + PC_RK + h * 64, cost + (size_t)(s0 + tl) * 32, sint + (size_t)(s0 + tl) * 32, hh, 0.125f, ka);
        bf16x8 xb[2][2];
#pragma unroll
        for (int dt = 0; dt < 2; ++dt) { f32x16 x;
#pragma unroll
            for (int k = 0; k < 16; ++k) x[k] = 0.f;
            x = MFMA32(ka[2 * dt], idm[0], x); x = MFMA32(ka[2 * dt + 1], idm[1], x);
            float xs[16];
#pragma unroll
            for (int i = 0; i < 16; ++i) xs[i] = x[i] * __builtin_amdgcn_exp2f((float)(127 - (32 * ti + 16 * hh + i)) * lg2);
            xb[dt][0] = pack8(xs); xb[dt][1] = pack8(xs + 8); }
#pragma unroll
        for (int et = 0; et < 2; ++et)
#pragma unroll
            for (int s = 0; s < 2; ++s) { const bf16x8 va = ld8(vT + (size_t)(VT_RV + h * 64 + 32 * et + cl) * T + R0 + 32 * ti + 16 * hh + 8 * s);
                kv[et][0] = MFMA32(va, xb[0][s], kv[et][0]); kv[et][1] = MFMA32(va, xb[1][s], kv[et][1]); }
    }
    float* retloc = (float*)(ws + WS_RETLOC) + (size_t)(uc * 8 + h) * 4096;
#pragma unroll
    for (int et = 0; et < 2; ++et)
#pragma unroll
        for (int dt = 0; dt < 2; ++dt)
#pragma unroll
            for (int i = 0; i < 16; ++i) { const int e = 32 * et + 8 * (i >> 2) + 4 * hh + (i & 3); retloc[e * 64 + 32 * dt + cl] = kv[et][dt][i]; }
}

__device__ __forceinline__ void ret_apply_unit(ArgsP a, int l, int uc, int lane, int h) {
    unsigned char* ws = a->ws;
    const bf16* proj = (const bf16*)(ws + WS_R1); const bf16* vT = (const bf16*)(ws + WS_VT); bf16* ymix = (bf16*)(ws + WS_R3);
    const bf16* prevT = (const bf16*)(ws + WS_RETPREV) + (size_t)(uc * 8 + h) * 4096;
    const float* cost = (const float*)(ws + WS_ROPE); const float* sint = cost + SEQ * 32;
    const float* gw = a->in[I_RETGW] + l * 512 + h * 64; const float* gb = a->in[I_RETGB] + l * 512 + h * 64;
    const int R0 = uc * CH, s0 = (uc & 127) * CH, cl = lane & 31, hh = lane >> 5;
    const float lg2 = ((const float*)(ws + WS_MOE + MO_RETLG))[h];
    bf16x8 kall[4][4];
#pragma unroll
    for (int qi = 0; qi < 4; ++qi) {
        const int ql = 32 * qi + cl;
        { const int kl = 32 * qi + tau(cl);
          load_rope(proj + (size_t)(R0 + kl) * NPROJ + PC_RK + h * 64, cost + (size_t)(s0 + kl) * 32, sint + (size_t)(s0 + kl) * 32, hh, 0.125f, kall[qi]);
 }
        bf16x8 qb[4]; load_rope(proj + (size_t)(R0 + ql) * NPROJ + PC_RQ + h * 64, cost + (size_t)(s0 + ql) * 32, sint + (size_t)(s0 + ql) * 32, hh, 1.0f, qb);
        f32x16 o[2];
        { const float gq1 = __builtin_amdgcn_exp2f((float)(ql + 1) * lg2);
#pragma unroll
          for (int et = 0; et < 2; ++et) { f32x16 ct;
#pragma unroll
              for (int k = 0; k < 16; ++k) ct[k] = 0.f;
#pragma unroll
              for (int s = 0; s < 4; ++s) { const bf16x8 pa = ld8(prevT + (32 * et + cl) * 64 + 16 * s + 8 * hh); ct = MFMA32(pa, qb[s], ct); }
#pragma unroll
              for (int k = 0; k < 16; ++k) o[et][k] = ct[k] * gq1; } }
#pragma unroll
        for (int ki = 0; ki < 4; ++ki) if (ki <= qi) {
            f32x16 st;
#pragma unroll
            for (int k = 0; k < 16; ++k) st[k] = 0.f;
#pragma unroll
            for (int s = 0; s < 4; ++s) st = MFMA32(kall[ki][s], qb[s], st);
            float pv[16];
#pragma unroll
            for (int i = 0; i < 16; ++i) { const int dl = ql - (32 * ki + 16 * hh + i); pv[i] = dl >= 0 ? st[i] * __builtin_amdgcn_exp2f((float)dl * lg2) : 0.f; }
            const bf16x8 pb0 = pack8(pv), pb1 = pack8(pv + 8);
#pragma unroll
            for (int et = 0; et < 2; ++et) { const bf16* vp = vT + (size_t)(VT_RV + h * 64 + 32 * et + cl) * T + R0 + 32 * ki + 16 * hh; o[et] = MFMA32(ld8(vp), pb0, o[et]); o[et] = MFMA32(ld8(vp + 8), pb1, o[et]); }
        }
        float sm = 0.f;
#pragma unroll
        for (int et = 0; et < 2; ++et)
#pragma unroll
            for (int i = 0; i < 16; ++i) sm += o[et][i];
        sm += __shfl_xor(sm, 32);
        const float mean = sm * (1.0f / 64.0f); float sq = 0.f;
#pragma unroll
        for (int et = 0; et < 2; ++et)
#pragma unroll
            for (int i = 0; i < 16; ++i) { const float d = o[et][i] - mean; sq += d * d; }
        sq += __shfl_xor(sq, 32);
        const float rstd = __builtin_amdgcn_rsqf(sq * (1.0f / 64.0f) + LN_EPS);
        const bf16* gp = proj + (size_t)(R0 + ql) * NPROJ + PC_RG + h * 64; bf16* yp = ymix + (size_t)(R0 + ql) * D + 256 + h * 64;
#pragma unroll
        for (int et = 0; et < 2; ++et)
#pragma unroll
            for (int q4 = 0; q4 < 4; ++q4) { const int e0 = 32 * et + 8 * q4 + 4 * hh;
                const f32x4 w4 = *(const f32x4*)(gw + e0), b4 = *(const f32x4*)(gb + e0); const u32x2 gr = *(const u32x2*)(gp + e0);
                const float g0 = __uint_as_float(gr.x << 16), g1 = __uint_as_float(gr.x & 0xffff0000u), g2 = __uint_as_float(gr.y << 16), g3 = __uint_as_float(gr.y & 0xffff0000u);
                const float v0 = ((o[et][4 * q4 + 0] - mean) * rstd * w4[0] + b4[0]) * pg8::fast_silu(g0), v1 = ((o[et][4 * q4 + 1] - mean) * rstd * w4[1] + b4[1]) * pg8::fast_silu(g1);
                const float v2 = ((o[et][4 * q4 + 2] - mean) * rstd * w4[2] + b4[2]) * pg8::fast_silu(g2), v3 = ((o[et][4 * q4 + 3] - mean) * rstd * w4[3] + b4[3]) * pg8::fast_silu(g3);
                u32x2 w; w.x = cvtpk(v0, v1); w.y = cvtpk(v2, v3); *(u32x2*)(yp + e0) = w; }
    }
}

__device__ __forceinline__ void sb_unit(ArgsP a, int l, int uc, int qi, int hd, int lane) {
    unsigned char* ws = a->ws;
    const bf16* proj = (const bf16*)(ws + WS_R1); const bf16* vT = (const bf16*)(ws + WS_VT); bf16* ymix = (bf16*)(ws + WS_R3);
    const int R0 = uc * CH, b = uc >> 7, s0 = (uc & 127) * CH, cl = lane & 31, hh = lane >> 5;
    const int qrow = R0 + 32 * qi + cl, qpos = s0 + 32 * qi + cl;
    bf16x8 qb[4];
#pragma unroll
    for (int s = 0; s < 4; ++s) qb[s] = ld8(proj + (size_t)qrow * NPROJ + PC_SQ + hd * 64 + 16 * s + 8 * hh);
    f32x16 o[2];
#pragma unroll
    for (int et = 0; et < 2; ++et)
#pragma unroll
        for (int k = 0; k < 16; ++k) o[et][k] = 0.f;
    float R = 0.f;
    int kt = (s0 >> 5) + qi;
    const bf16* kp0 = proj + (size_t)(b * SEQ + tau(cl)) * NPROJ + PC_SK + hd * 64 + 8 * hh;
    const bf16* vp0 = vT + (size_t)(VT_SV + hd * 64 + cl) * T + b * SEQ + 16 * hh;
    bf16x8 kc[4], vc[4];
#pragma unroll
    for (int s = 0; s < 4; ++s) kc[s] = ld8(kp0 + (size_t)(32 * kt) * NPROJ + 16 * s);
#pragma unroll
    for (int et = 0; et < 2; ++et) { vc[2 * et] = ld8(vp0 + (size_t)(32 * et) * T + 32 * kt); vc[2 * et + 1] = ld8(vp0 + (size_t)(32 * et) * T + 32 * kt + 8); }
    for (;;) {
        const int ktn = kt > 0 ? kt - 1 : 0;
        bf16x8 kn[4], vn[4];
#pragma unroll
        for (int s = 0; s < 4; ++s) kn[s] = ld8(kp0 + (size_t)(32 * ktn) * NPROJ + 16 * s);
#pragma unroll
        for (int et = 0; et < 2; ++et) { vn[2 * et] = ld8(vp0 + (size_t)(32 * et) * T + 32 * ktn); vn[2 * et + 1] = ld8(vp0 + (size_t)(32 * et) * T + 32 * ktn + 8); }
        f32x16 st;
#pragma unroll
        for (int k = 0; k < 16; ++k) st[k] = 0.f;
#pragma unroll
        for (int s = 0; s < 4; ++s) st = MFMA32(kc[s], qb[s], st);
        float lb[16], aft[16]; float run = 0.f;
#pragma unroll
        for (int i = 15; i >= 0; --i) { const float z = st[i] * 0.125f; const bool valid = (32 * kt + 16 * hh + i) < qpos;
            const float sp = fmaxf(z, 0.f) + __logf(1.0f + __expf(-fabsf(z)));
            lb[i] = valid ? (z - sp) : -1.0e30f;
            aft[i] = run; run += valid ? -sp : 0.f; }
        const float oth = __shfl_xor(run, 32);
        const float off = R + (hh == 0 ? oth : 0.f);
        float pv[16];
#pragma unroll
        for (int i = 0; i < 16; ++i) pv[i] = __expf(lb[i] + aft[i] + off);
        R += run + oth;
        const bf16x8 pb0 = pack8(pv), pb1 = pack8(pv + 8);
#pragma unroll
        for (int et = 0; et < 2; ++et) { o[et] = MFMA32(vc[2 * et], pb0, o[et]); o[et] = MFMA32(vc[2 * et + 1], pb1, o[et]); }
        if (kt == 0 || __all(R < -SB_THR)) break;
        kt = ktn;
#pragma unroll
        for (int s = 0; s < 4; ++s) { kc[s] = kn[s]; vc[s] = vn[s]; }
    }
    float ss = 0.f;
#pragma unroll
    for (int et = 0; et < 2; ++et)
#pragma unroll
        for (int i = 0; i < 16; ++i) ss += o[et][i] * o[et][i];
    ss += __shfl_xor(ss, 32);
    const float r = __builtin_amdgcn_rsqf(ss * (1.0f / 64.0f) + LN_EPS);
    const float* nw = a->in[I_SBNW] + l * 256 + hd * 64; bf16* yp = ymix + (size_t)qrow * D + 768 + hd * 64;
#pragma unroll
    for (int et = 0; et < 2; ++et)
#pragma unroll
        for (int q4 = 0; q4 < 4; ++q4) { const int e0 = 32 * et + 8 * q4 + 4 * hh; const f32x4 w4 = *(const f32x4*)(nw + e0);
            u32x2 w; w.x = cvtpk(o[et][4 * q4 + 0] * r * w4[0], o[et][4 * q4 + 1] * r * w4[1]); w.y = cvtpk(o[et][4 * q4 + 2] * r * w4[2], o[et][4 * q4 + 3] * r * w4[3]); *(u32x2*)(yp + e0) = w; }
}

__device__ __forceinline__ void carry_phase(ArgsP a, int l, int tid) {
    unsigned char* ws = a->ws;
    const int gt = blockIdx.x * (NWAVES * 64) + tid, GT = gridDim.x * NWAVES * 64;
    for (int idx = gt; idx < BATCH * 8 * 4096; idx += GT) {
        const int b = idx >> 15, h = (idx >> 12) & 7, ed = idx & 4095;
        const float dec = __builtin_amdgcn_exp2f(128.0f * ((const float*)(ws + WS_MOE + MO_RETLG))[h]);
        const float* loc = (const float*)(ws + WS_RETLOC) + (size_t)(b * 128 * 8 + h) * 4096 + ed; bf16* prv = (bf16*)(ws + WS_RETPREV) + (size_t)(b * 128 * 8 + h) * 4096 + ed;
        float S = 0.f;
#pragma unroll 8
        for (int c = 0; c < 128; ++c) { const float v = loc[(size_t)c * 8 * 4096]; prv[(size_t)c * 8 * 4096] = (unsigned short)(cvtpk(S, 0.f) & 0xffffu); S = dec * S + v; }
    }
    for (int idx = GT - 1 - gt; idx < BATCH * 16 * 64; idx += GT) {
        const int b = idx >> 10, g = (idx >> 6) & 15, p = idx & 63, lg = l * 16 + g;
        const f32x4 tb4 = *(const f32x4*)((const float*)(ws + WS_MOE + MO_S5TAB) + (size_t)(lg * 64 + p) * 8 + 4);
        const float ar = tb4[0], ai = tb4[1];
        const f32x2* loc = (const f32x2*)(ws + WS_S5LOC) + (size_t)(b * 128 * 16 + g) * 64 + p; f32x2* car = (f32x2*)(ws + WS_S5CAR) + (size_t)(b * 128 * 16 + g) * 64 + p;
        float xr = 0.f, xi = 0.f;
#pragma unroll 8
        for (int c = 0; c < 128; ++c) { const f32x2 v = loc[(size_t)c * 16 * 64]; car[(size_t)c * 16 * 64] = (f32x2){xr, xi}; const float nr = ar * xr - ai * xi + v.x, ni = ar * xi + ai * xr + v.y; xr = nr; xi = ni; }
    }
}

#define RELAUNDER() do { int t_ = threadIdx.x; asm volatile("" : "+v"(t_)); tid = t_; lane = tid & 63; wave = __builtin_amdgcn_readfirstlane(tid >> 6); int g_ = gridDim.x, b_ = blockIdx.x; asm volatile("" : "+s"(g_), "+s"(b_)); G = g_; bid = b_; \
        ArgsP p_ = (ArgsP)__builtin_amdgcn_kernarg_segment_ptr(); asm volatile("" : "+s"(p_)); ap = p_; ws = ap->ws; } while (0)
#define GRID_BAR() do { xcd_barrier(bar); RELAUNDER(); } while (0)
#define LAUNDER_LANE() do { int t_ = threadIdx.x; asm volatile("" : "+v"(t_)); tid = t_; lane = tid & 63; wave = __builtin_amdgcn_readfirstlane(tid >> 6); } while (0)
#define xb ((bf16*)(ws + WS_R2))
#define proj ((bf16*)(ws + WS_R1))
#define vT ((bf16*)(ws + WS_VT))
#define ymix ((bf16*)(ws + WS_R3))
#define out (ap->out)


template <int l>
__device__ __forceinline__ void layer_body(const XcdBarrier& bar, LAS unsigned char* lds) {
    int tid, lane, wave, G, bid; ArgsP ap; unsigned char* ws;
    RELAUNDER();
#ifndef NO_G0
        { static_assert(WS_R2 % (256 * 1024 * 2) == 0 && WS_WIN % (256 * 1024 * 2) == 0, "x and weight copies sit on 512 KiB tile boundaries of the workspace");
          pg8::Gemm g{(const bf16*)ws, (const bf16*)ws, T, NPROJ, D}; pg8::ProjOrder S; S.init(G, bid, (int)(WS_R2 / (512 * 1024)), (int)(WS_WIN / (512 * 1024)) + 12 * l);
          pg8::EpiProj E{proj, NPROJ, vT, T};
          pg8::gemm_phase<pg8::EpiProj, pg8::ProjOrder, PG8_ALIGN, PG8_SP2>(lds + RING_OFF, g, S, E); }
#endif
        GRID_BAR();
        for (int uc = bid; uc < NUC; uc += G) {
#ifndef NO_S5L
            LAUNDER_LANE();
            s5_unit<false>(ap, l, uc, lds, tid, lane, wave);
#endif
#ifndef NO_RETL
            LAUNDER_LANE();
            ret_local_unit(ap, uc, lane, wave);
#endif
#ifndef NO_SB
            LAUNDER_LANE();
            sb_unit(ap, l, uc, wave >> 2, wave & 3, lane);
            LAUNDER_LANE();
            sb_unit(ap, l, uc, 2 + (wave >> 2), wave & 3, lane);
#endif
        }
        GRID_BAR();
#ifndef NO_CARRY
        carry_phase(ap, l, tid);
#endif
        GRID_BAR();
        for (int uc = bid; uc < NUC; uc += G) {
#ifndef NO_S5A
            LAUNDER_LANE();
            s5_unit<true>(ap, l, uc, lds, tid, lane, wave);
#endif
#ifndef NO_RETA
            LAUNDER_LANE();
            ret_apply_unit(ap, l, uc, lane, wave);
#endif
        }
        GRID_BAR();
#ifndef NO_G2
        { int kglu = 256; asm volatile("" : "+s"(kglu));
          pg8::Gemm g{(const bf16*)(ws + WS_GBUF), (const bf16*)(ws + WS_GLU) + (size_t)l * 65536, T, 256, kglu}; pg8::StaticOrder S; S.init(T, 256, G, bid);
          pg8::EpiGLU E{(const bf16*)(ws + WS_GBUF), ap->in[I_GLUB] + l * 256, ap->in[I_SSMNW] + l * 256, ymix, D, LN_EPS};
          pg8::gemm_phase<pg8::EpiGLU, pg8::StaticOrder, PG8_ALIGN, PG8_SP2>(lds + RING_OFF, g, S, E); }
#endif
        GRID_BAR();
#ifndef NO_G3
        { pg8::Gemm g{ymix, (const bf16*)(ws + WS_WOUT) + (size_t)l * D * D, T, D, D}; pg8::StaticOrder S; S.init(T, D, G, bid);
          pg8::EpiResF32 E{l == 0 ? ap->in[I_X] : out, out, D, ALPHA};
          pg8::gemm_phase<pg8::EpiResF32, pg8::StaticOrder, PG8_ALIGN, PG8_SP2>(lds + RING_OFF, g, S, E); }
#endif
        GRID_BAR();
        const int li = l >> 1;
        if (l & 1) {
#ifndef NO_LN
            ln_phase<1>(ap, ap->in[I_LNMW] + l * D, ap->in[I_LNMB] + l * D, ap->in[I_ROUTER] + (size_t)li * D * NE, lds, tid, lane, wave);
#endif
            GRID_BAR();
#ifndef NO_LN
            moe_gather_phase(ap, lds, tid, lane, wave);
#endif
            GRID_BAR();
            const int np = (int)__builtin_amdgcn_readfirstlane(__hip_atomic_load((unsigned*)ws + CW_NP, RLX_AGENT));
            const int* panel_exp = (const int*)(ws + WS_MOE + MO_PANEL);
#ifndef NO_G4
            { pg8::Gemm g{(const bf16*)(ws + WS_R1), (const bf16*)(ws + WS_MGU) + (size_t)li * NE * 1536 * 1024, np * 256, 1536, D}; pg8::MoeOrder S{panel_exp, 6, np * 6, G, bid};
              pg8::EpiSwiGLU<true> E{(bf16*)(ws + WS_R2), EFFP, (const float*)(ws + WS_MOE + MO_ROWW)};
              pg8::gemm_phase<pg8::EpiSwiGLU<true>, pg8::MoeOrder, PG8_ALIGN, PG8_SP2>(lds + RING_OFF, g, S, E); }
#endif
            GRID_BAR();
#ifndef NO_G5
            { pg8::Gemm g{(const bf16*)(ws + WS_R2), (const bf16*)(ws + WS_MDN) + (size_t)li * NE * 1024 * EFFP, np * 256, D, EFFP}; pg8::MoeOrder S{panel_exp, 4, np * 4, G, bid};
              pg8::EpiStoreBf16 E{(bf16*)(ws + WS_R1), D};
              pg8::gemm_phase<pg8::EpiStoreBf16, pg8::MoeOrder, PG8_ALIGN, PG8_SP2>(lds + RING_OFF, g, S, E); }
#endif
            GRID_BAR();
#ifndef NO_LN
            ln_phase<2>(ap, ap->in[I_LNFW] + l * D, ap->in[I_LNFB] + l * D, nullptr, lds, tid, lane, wave);
#endif
            GRID_BAR();
        } else {
#ifndef NO_LN
            ln_phase<0>(ap, ap->in[I_LNMW] + l * D, ap->in[I_LNMB] + l * D, nullptr, lds, tid, lane, wave);
#endif
            GRID_BAR();
#ifndef NO_G6
            { pg8::Gemm g{xb, (const bf16*)(ws + WS_FGU) + (size_t)li * 5632 * 1024, T, 5632, D}; pg8::StaticOrder S; S.init(T, 5632, G, bid);
              pg8::EpiSwiGLU<false> E{(bf16*)(ws + WS_R1), DFFP, nullptr};
              pg8::gemm_phase<pg8::EpiSwiGLU<false>, pg8::StaticOrder, PG8_ALIGN, PG8_SP2>(lds + RING_OFF, g, S, E); }
#endif
            GRID_BAR();
#ifndef NO_G7
            { pg8::Gemm g{(const bf16*)(ws + WS_R1), (const bf16*)(ws + WS_FDN) + (size_t)li * 1024 * DFFP, T, D, DFFP}; pg8::StaticOrder S; S.init(T, D, G, bid);
              pg8::EpiResF32 E{out, out, D, ALPHA};
              pg8::gemm_phase<pg8::EpiResF32, pg8::StaticOrder, PG8_ALIGN, PG8_SP2>(lds + RING_OFF, g, S, E); }
#endif
            GRID_BAR();
#ifndef NO_LN
            ln_phase<0>(ap, ap->in[I_LNFW] + l * D, ap->in[I_LNFB] + l * D, nullptr, lds, tid, lane, wave);
#endif
            GRID_BAR();
        }
}

__global__ void __launch_bounds__(NWAVES * 64, 2) hybrid_fwd(Args args) {
    extern __shared__ __attribute__((aligned(16))) unsigned char lds_raw[];
    LAS unsigned char* lds = (LAS unsigned char*)lds_raw;
    int tid, lane, wave, G, bid; ArgsP ap; unsigned char* ws;
    RELAUNDER();
    for (int u = tid; u < (LDS_BYTES - LDSCTL_OFF) / 4; u += NWAVES * 64) ((LAS unsigned*)(lds + LDSCTL_OFF))[u] = 0u;
    __syncthreads();
    XcdBarrier bar = xcd_barrier_post((unsigned*)(ws + WS_CTL) + CW_BAR, (volatile LAS unsigned*)(lds + MISC_OFF) + 8);
#ifndef NO_P0
    p0_prologue(ap, lds, tid, lane, wave);
#endif
    GRID_BAR();
    layer_body<0>(bar, lds); layer_body<1>(bar, lds); layer_body<2>(bar, lds); layer_body<3>(bar, lds);
#undef GRID_BAR
#undef RELAUNDER
#undef LAUNDER_LANE
#undef xb
#undef proj
#undef vT
#undef ymix
#undef out
}

extern "C" void kernel_launch(void* const* d_in, const int* in_sizes, int n_in, void* d_out, int out_size, void* d_ws, size_t ws_size, hipStream_t stream) {
    static int grid = 0;
    if (grid == 0) {
        if (n_in != 28 || out_size != T * D || ws_size < WS_END) { fprintf(stderr, "kernel_launch: unexpected problem shape (n_in %d, out %d, ws %zu); nothing launched\n", n_in, out_size, ws_size); grid = -1; return; }
        int dev = 0, cus = 0, per_cu = 0;
        if (hipGetDevice(&dev) != hipSuccess || hipDeviceGetAttribute(&cus, hipDeviceAttributeMultiprocessorCount, dev) != hipSuccess) { grid = -1; return; }
        if (hipFuncSetAttribute((const void*)hybrid_fwd, hipFuncAttributeMaxDynamicSharedMemorySize, LDS_BYTES) != hipSuccess) { fprintf(stderr, "kernel_launch: hipFuncSetAttribute failed\n"); grid = -1; return; }
        if (hipOccupancyMaxActiveBlocksPerMultiprocessor(&per_cu, (const void*)hybrid_fwd, NWAVES * 64, LDS_BYTES) != hipSuccess || per_cu < 1)
            fprintf(stderr, "kernel_launch: note: occupancy query reports %d workgroups per CU\n", per_cu);
        (void)hipGetLastError();
        grid = cus < 256 ? cus : 256;
    }
    if (grid < 0) return;
    if (hipMemsetAsync((char*)d_ws + WS_CTL, 0, CTL_ZERO_BYTES, stream) != hipSuccess) return;
    Args a{};
    for (int i = 0; i < 28; ++i) a.in[i] = (const float*)d_in[i];
    a.out = (float*)d_out; a.ws = (unsigned char*)d_ws;
    hipLaunchKernelGGL(hybrid_fwd, dim3(grid), dim3(NWAVES * 64), LDS_BYTES, stream, a);
}
```
